# Optimizing an MI355X kernel written in HIP

```python
import jax
import jax.numpy as jnp
from jax import lax
import numpy as np

D_MODEL = 1024
BATCH = 32
SEQ = 2048
DEPTH = 1

GRID_W = 64
CTX_LEN = 256
CTX_CHUNK = 64
N_MOD = 6
EPS = 1e-6

HG_HEADS = 8
HG_HEAD_K = 128
HG_HEAD_V = D_MODEL // HG_HEADS
HG_KEY = HG_HEADS * HG_HEAD_K
HG_VAL = HG_HEADS * HG_HEAD_V

GLA_HEADS = 4
GLA_KEY = D_MODEL // 2
GLA_VAL = D_MODEL
GLA_HEAD_K = GLA_KEY // GLA_HEADS
GLA_HEAD_V = GLA_VAL // GLA_HEADS
GLA_GATE_RANK = 16
GLA_GATE_NORMALIZER = 16.0

IN_SIZES = (HG_KEY, HG_KEY, HG_KEY, HG_VAL, HG_VAL,
            GLA_KEY, GLA_KEY, GLA_VAL, GLA_VAL, GLA_GATE_RANK, GLA_GATE_RANK,
            D_MODEL, D_MODEL)
D_IN = 3 * HG_KEY + 2 * HG_VAL + 2 * GLA_KEY + 2 * GLA_VAL + 2 * GLA_GATE_RANK + 2 * D_MODEL

PEER_HEADS = 8
PEER_N_KEYS = 128
PEER_EXPERTS = PEER_N_KEYS * PEER_N_KEYS
PEER_QUERY_DIM = 256
PEER_SUB_DIM = PEER_QUERY_DIM // 2
PEER_TOPK = 16
PEER_BLOCK = 128

kernel_name = "hybrid_hgrn2_gla_peer_dit_layer"


def rmsnorm(x, g):
    xf = x.astype(jnp.float32)
    xf = xf * lax.rsqrt(jnp.mean(xf * xf, axis=-1, keepdims=True) + EPS)
    return (xf * g.astype(jnp.float32)).astype(x.dtype)


def modulate(h, shift, scale):
    return h * (1.0 + scale) + shift


def to_heads(a, n_heads):
    bsz, t, _ = a.shape
    return a.reshape(bsz, t, n_heads, -1).transpose(0, 2, 1, 3)


def flip_t(a):
    return a[:, :, ::-1]


def hgrn_lower_bounds(logits):
    p = jax.nn.softmax(logits.astype(jnp.float32), axis=0)
    return jnp.cumsum(p, axis=0)[:DEPTH]


def hgrn_forget(z, lb):
    f = lb + (1.0 - lb) * jax.nn.sigmoid(z.astype(jnp.float32))
    return 1.0 - f, jnp.log(f)


def chunk_gla(q, k, v, log_g, s0, n_chunks):
    bsz, nh, t, _ = q.shape
    dv = v.shape[-1]
    chunk = t // n_chunks

    def blocks(a):
        return jnp.moveaxis(a.reshape(bsz, nh, n_chunks, chunk, a.shape[-1]), 2, 0)

    qc, kc, vc = blocks(q), blocks(k), blocks(v)
    b = jnp.cumsum(blocks(log_g).astype(jnp.float32), axis=3)
    b_last = b[:, :, :, chunk - 1:chunk]
    b_ref = b[:, :, :, chunk // 2:chunk // 2 + 1]
    scores = jnp.einsum("nbhck,nbhsk->nbhcs", qc * jnp.exp(b - b_ref), kc * jnp.exp(b_ref - b))
    causal_in_scan = jnp.tril(jnp.ones((chunk, chunk), dtype=bool))
    o_intra = jnp.einsum("nbhcs,nbhsv->nbhcv", jnp.where(causal_in_scan, scores, 0.0), vc)
    q_dec = qc * jnp.exp(b)
    k_dec = kc * jnp.exp(b_last - b)

    def step(state, inp):
        q_i, k_i, v_i, bl = inp
        o_inter = jnp.einsum("bhck,bhkv->bhcv", q_i, state)
        state = jnp.exp(bl)[:, :, 0, :, None] * state + jnp.einsum("bhsk,bhsv->bhkv", k_i, v_i)
        return state, o_inter

    _, o_inter = lax.scan(step, s0, (q_dec, k_dec, vc, b_last))
    o = o_intra + o_inter
    return jnp.moveaxis(o, 0, 2).reshape(bsz, nh, t, dv)


def final_state(k, v, log_g):
    b = jnp.cumsum(log_g.astype(jnp.float32), axis=2)
    return jnp.einsum("bhtk,bhtv->bhkv", k * jnp.exp(b[:, :, -1:] - b), v)


def mixer_inputs(h, w_in, lb, gk_w, gk_b):
    splits = [int(s) for s in np.cumsum(IN_SIZES)[:-1]]
    (hq, hf_fwd, hf_bwd, hi, hg, gq, gk, gv, gg, gr_fwd, gr_bwd, m_hg, m_gla) = jnp.split(
        h @ w_in, splits, axis=-1)
    hk_fwd, hlf_fwd = hgrn_forget(hf_fwd, lb[0])
    hk_bwd, hlf_bwd = hgrn_forget(hf_bwd, lb[1])
    glf_fwd = jax.nn.log_sigmoid((gr_fwd @ gk_w[0] + gk_b[0]).astype(jnp.float32)) / GLA_GATE_NORMALIZER
    glf_bwd = jax.nn.log_sigmoid((gr_bwd @ gk_w[1] + gk_b[1]).astype(jnp.float32)) / GLA_GATE_NORMALIZER
    gla_k = to_heads(gk, GLA_HEADS)
    return {
        "hg_q": to_heads(hq, HG_HEADS) * HG_HEAD_K ** -0.5,
        "hg_v": to_heads(hi, HG_HEADS),
        "hg_k": (to_heads(hk_fwd, HG_HEADS), to_heads(hk_bwd, HG_HEADS)),
        "hg_lg": (to_heads(hlf_fwd, HG_HEADS), to_heads(hlf_bwd, HG_HEADS)),
        "hg_gate": hg,
        "gla_q": to_heads(gq, GLA_HEADS) * GLA_HEAD_K ** -0.5,
        "gla_v": to_heads(gv, GLA_HEADS),
        "gla_k": (gla_k, gla_k),
        "gla_lg": (to_heads(glf_fwd, GLA_HEADS), to_heads(glf_bwd, GLA_HEADS)),
        "gla_gate": gg,
        "merge": (m_hg, m_gla),
    }


def context_states(t):
    def both(k_pair, v, lg_pair):
        return (final_state(k_pair[0], v, lg_pair[0]),
                final_state(flip_t(k_pair[1]), flip_t(v), flip_t(lg_pair[1])))
    return {"hg": both(t["hg_k"], t["hg_v"], t["hg_lg"]),
            "gla": both(t["gla_k"], t["gla_v"], t["gla_lg"])}


def zero_states(bsz):
    hg = jnp.zeros((bsz, HG_HEADS, HG_HEAD_K, HG_HEAD_V), jnp.float32)
    gla = jnp.zeros((bsz, GLA_HEADS, GLA_HEAD_K, GLA_HEAD_V), jnp.float32)
    return {"hg": (hg, hg), "gla": (gla, gla)}


def bidir(q, k_pair, v, lg_pair, s_pair, n_chunks):
    o_fwd = chunk_gla(q, k_pair[0], v, lg_pair[0], s_pair[0], n_chunks)
    o_bwd = chunk_gla(flip_t(q), flip_t(k_pair[1]), flip_t(v), flip_t(lg_pair[1]), s_pair[1], n_chunks)
    return o_fwd + flip_t(o_bwd)


def gated_head_norm(o, gate, g):
    bsz, nh, t, dv = o.shape
    on = rmsnorm(o.transpose(0, 2, 1, 3), g)
    y = on * jax.nn.silu(gate.astype(jnp.float32)).reshape(bsz, t, nh, dv)
    return y.reshape(bsz, t, nh * dv).astype(gate.dtype)


def mixer_output(t, states, n_chunks, hg_norm_g, gla_norm_g, w_br_hg, w_br_gla, w_o):
    o_hg = bidir(t["hg_q"], t["hg_k"], t["hg_v"], t["hg_lg"], states["hg"], n_chunks)
    o_gla = bidir(t["gla_q"], t["gla_k"], t["gla_v"], t["gla_lg"], states["gla"], n_chunks)
    y_hg = gated_head_norm(o_hg, t["hg_gate"], hg_norm_g) @ w_br_hg
    y_gla = gated_head_norm(o_gla, t["gla_gate"], gla_norm_g) @ w_br_gla
    m_hg, m_gla = t["merge"]
    y = jax.nn.sigmoid(m_hg) * y_hg + jax.nn.sigmoid(m_gla) * y_gla
    return y @ w_o


def peer(h, wq, k1, k2, u, v):
    bsz, t, d = h.shape
    tok = h.reshape(bsz * t, d)
    q = (tok @ wq).reshape(-1, PEER_HEADS, 2, PEER_SUB_DIM)
    s1 = jnp.einsum("nhd,kd->nhk", q[:, :, 0], k1).astype(jnp.float32)
    s2 = jnp.einsum("nhd,kd->nhk", q[:, :, 1], k2).astype(jnp.float32)
    v1, i1 = lax.top_k(s1, PEER_TOPK)
    v2, i2 = lax.top_k(s2, PEER_TOPK)
    cand = (v1[..., :, None] + v2[..., None, :]).reshape(-1, PEER_HEADS, PEER_TOPK * PEER_TOPK)
    top_s, top_c = lax.top_k(cand, PEER_TOPK)
    expert = (jnp.take_along_axis(i1, top_c // PEER_TOPK, axis=-1) * PEER_N_KEYS
              + jnp.take_along_axis(i2, top_c % PEER_TOPK, axis=-1))
    gate = jax.nn.softmax(top_s, axis=-1)
    n_sel = PEER_HEADS * PEER_TOPK

    def expert_block(args):
        xb, eb, gb = args
        act = jax.nn.gelu(jnp.einsum("pd,ped->pe", xb, jnp.take(u, eb, axis=0)), approximate=False)
        return jnp.einsum("pe,ped->pd", (gb * act).astype(v.dtype), jnp.take(v, eb, axis=0))

    out = lax.map(expert_block, (tok.reshape(-1, PEER_BLOCK, d),
                                 expert.reshape(-1, PEER_BLOCK, n_sel),
                                 gate.reshape(-1, PEER_BLOCK, n_sel)))
    return out.reshape(bsz, t, d).astype(h.dtype)


def setup_inputs(seed: int = 0) -> dict:
    key = jax.random.key(seed)
    ks = jax.random.split(key, 24)

    def nrm(k, shape, scale):
        return jax.random.normal(k, shape, jnp.float32) * scale

    def gain(k, shape):
        return 1.0 + 0.1 * jax.random.normal(k, shape, jnp.float32)

    return {
        "x": nrm(ks[0], (BATCH, SEQ, D_MODEL), 1.0),
        "c": nrm(ks[1], (BATCH, D_MODEL), 1.0),
        "ctx": nrm(ks[2], (BATCH, CTX_LEN, D_MODEL), 1.0),
        "c_ctx": nrm(ks[3], (D_MODEL,), 1.0),
        "ada_w": nrm(ks[4], (DEPTH, D_MODEL, N_MOD * D_MODEL), 0.5 * D_MODEL ** -0.5),
        "ada_b": nrm(ks[5], (DEPTH, N_MOD * D_MODEL), 0.02),
        "norm_mix_g": gain(ks[6], (DEPTH, D_MODEL)),
        "w_in": nrm(ks[7], (DEPTH, D_MODEL, D_IN), D_MODEL ** -0.5),
        "hgrn_lb_logits": nrm(ks[8], (DEPTH + 1, 2, HG_KEY), 0.5),
        "hgrn_norm_g": gain(ks[9], (DEPTH, HG_HEAD_V)),
        "gla_gk_w": nrm(ks[10], (DEPTH, 2, GLA_GATE_RANK, GLA_KEY), GLA_GATE_RANK ** -0.5),
        "gla_gk_b": nrm(ks[11], (DEPTH, 2, GLA_KEY), 0.1),
        "gla_norm_g": gain(ks[12], (DEPTH, GLA_HEAD_V)),
        "w_branch_hgrn": nrm(ks[13], (DEPTH, HG_VAL, D_MODEL), HG_VAL ** -0.5),
        "w_branch_gla": nrm(ks[14], (DEPTH, GLA_VAL, D_MODEL), GLA_VAL ** -0.5),
        "w_out": nrm(ks[15], (DEPTH, D_MODEL, D_MODEL), D_MODEL ** -0.5),
        "norm_ffn_g": gain(ks[16], (DEPTH, D_MODEL)),
        "peer_wq": nrm(ks[17], (DEPTH, D_MODEL, PEER_HEADS * PEER_QUERY_DIM), D_MODEL ** -0.5),
        "peer_k1": nrm(ks[18], (DEPTH, PEER_N_KEYS, PEER_SUB_DIM), PEER_SUB_DIM ** -0.5),
        "peer_k2": nrm(ks[19], (DEPTH, PEER_N_KEYS, PEER_SUB_DIM), PEER_SUB_DIM ** -0.5),
        "peer_u": nrm(ks[20], (DEPTH, PEER_EXPERTS, D_MODEL), D_MODEL ** -0.5),
        "peer_v": nrm(ks[21], (DEPTH, PEER_EXPERTS, D_MODEL), (PEER_HEADS * PEER_TOPK) ** -0.5),
        "final_g": gain(ks[22], (D_MODEL,)),
    }


def reference(x, c, ctx, c_ctx, ada_w, ada_b, norm_mix_g, w_in, hgrn_lb_logits, hgrn_norm_g,
              gla_gk_w, gla_gk_b, gla_norm_g, w_branch_hgrn, w_branch_gla, w_out, norm_ffn_g,
              peer_wq, peer_k1, peer_k2, peer_u, peer_v, final_g):
    bsz, seq, _ = x.shape
    rows = seq // GRID_W
    ctx_chunks = ctx.shape[1] // CTX_CHUNK
    lower = hgrn_lower_bounds(hgrn_lb_logits)
    silu_c = jax.nn.silu(c)
    silu_cc = jax.nn.silu(c_ctx)[None]
    xc = ctx
    for l in range(DEPTH):
        mod = jnp.split((silu_c @ ada_w[l] + ada_b[l])[:, None, :], N_MOD, axis=-1)
        mod_c = jnp.split((silu_cc @ ada_w[l] + ada_b[l])[:, None, :], N_MOD, axis=-1)
        mix_w = (hgrn_norm_g[l], gla_norm_g[l], w_branch_hgrn[l], w_branch_gla[l], w_out[l])
        peer_w = (peer_wq[l], peer_k1[l], peer_k2[l], peer_u[l], peer_v[l])
        t_ctx = mixer_inputs(modulate(rmsnorm(xc, norm_mix_g[l]), mod_c[0], mod_c[1]),
                             w_in[l], lower[l], gla_gk_w[l], gla_gk_b[l])
        t_lat = mixer_inputs(modulate(rmsnorm(x, norm_mix_g[l]), mod[0], mod[1]),
                             w_in[l], lower[l], gla_gk_w[l], gla_gk_b[l])
        x = x + mod[2] * mixer_output(t_lat, context_states(t_ctx), rows, *mix_w)
        x = x + mod[5] * peer(modulate(rmsnorm(x, norm_ffn_g[l]), mod[3], mod[4]), *peer_w)
        if l < DEPTH - 1:
            xc = xc + mod_c[2] * mixer_output(t_ctx, zero_states(bsz), ctx_chunks, *mix_w)
            xc = xc + mod_c[5] * peer(modulate(rmsnorm(xc, norm_ffn_g[l]), mod_c[3], mod_c[4]), *peer_w)
    return rmsnorm(x, final_g)
```

```cpp
#include <hip/hip_runtime.h>
#include <hip/hip_cooperative_groups.h>
#include <cstdio>

#define DBG 0
#ifndef DUP
#define DUP 0
#endif
namespace cg = cooperative_groups;

typedef unsigned short bf16_t;
typedef short bf16x8 __attribute__((ext_vector_type(8)));
typedef float f32x16 __attribute__((ext_vector_type(16)));
typedef __bf16 bfv2 __attribute__((ext_vector_type(2)));

constexpr int D = 1024, BATCH = 32, SEQ = 2048, CTXL = 256;
constexpr int NTOK = BATCH * SEQ;
constexpr int NG = 4, GB = 8;
constexpr int GLAT = GB * SEQ;
constexpr int GCTX = GB * CTXL;
constexpr int GROWS = GLAT + GCTX;
constexpr int NW = 11264;
constexpr int PW = 13312;
constexpr int DIN = 10272;
constexpr int NMOD = 6144;
constexpr int KSPL = 8;
constexpr float EPS = 1e-6f;
constexpr int C_HQ = 0, C_HKF = 1024, C_HLF = 2048, C_HKB = 3072, C_HLB = 4096, C_HV = 5120, C_HSG = 6144,
              C_GQ = 7168, C_GK = 7680, C_GV = 8192, C_GSG = 9216, C_MH = 10240, C_MG = 11264, C_GLF = 12288, C_GLB = 12800;

constexpr size_t MiB = 1024 * 1024;
constexpr size_t OFF_WIN = 0;
constexpr size_t OFF_WBRH = OFF_WIN + (size_t)NW * 1024 * 2;
constexpr size_t OFF_WBRG = OFF_WBRH + 2 * MiB;
constexpr size_t OFF_WO = OFF_WBRG + 2 * MiB;
constexpr size_t OFF_WQ = OFF_WO + 2 * MiB;
constexpr size_t OFF_K1 = OFF_WQ + 4 * MiB;
constexpr size_t OFF_K2 = OFF_K1 + 32768;
constexpr size_t OFF_U = OFF_K2 + 32768;
constexpr size_t OFF_V = OFF_U + 32 * MiB;
constexpr size_t OFF_MODP = OFF_V + 32 * MiB;
constexpr size_t OFF_MOD = OFF_MODP + (size_t)KSPL * 33 * NMOD * 4;
constexpr size_t OFF_LB = OFF_MOD + (size_t)33 * NMOD * 4;
constexpr size_t OFF_BAR = OFF_LB + 8192;
constexpr size_t OFF_US = OFF_BAR + 16384;
constexpr size_t OFF_VS = OFF_US + 65536;
constexpr size_t OFF_SS = OFF_VS + 65536;
constexpr size_t OFF_H = OFF_SS + 262144;
constexpr size_t OFF_PROJ = OFF_H + (size_t)GROWS * 1024 * 2;
constexpr size_t OFF_O = OFF_PROJ + (size_t)GROWS * PW * 2;
constexpr size_t OFF_YN = OFF_O + (size_t)4 * GLAT * 1024 * 2;
constexpr size_t OFF_Y1 = OFF_YN + (size_t)2 * GLAT * 1024 * 2;
constexpr size_t OFF_Y = OFF_Y1 + (size_t)GLAT * 1024 * 4;
constexpr size_t WS_END = OFF_Y + (size_t)GLAT * 1024 * 2;
constexpr size_t OFF_H2 = OFF_PROJ;
constexpr size_t OFF_Q = OFF_H2 + (size_t)NTOK * 1024 * 2;
constexpr size_t OFF_SIDX = OFF_Q + (size_t)NTOK * 2048 * 2;
constexpr size_t OFF_SGATE = OFF_SIDX + (size_t)NTOK * 128 * 4;
constexpr size_t OFF_PW = OFF_Q + (size_t)NTOK * 1024 * 2;
static_assert(OFF_SGATE + (size_t)NTOK * 128 * 4 <= OFF_O, "peer alias overflow");
static_assert(WS_END <= 1024 * MiB, "workspace too large");

constexpr int HALF_SMEM = 79360;
constexpr int SMEM_BYTES = 2 * HALF_SMEM + 16;

struct Params {
    const float *x, *c, *ctx, *c_ctx, *ada_w, *ada_b, *norm_mix_g, *w_in, *lb_logits, *hg_norm_g, *gk_w, *gk_b, *gla_norm_g,
        *w_br_hg, *w_br_gla, *w_out, *norm_ffn_g, *wq, *k1, *k2, *u, *v, *final_g;
    float* out;
    char* ws;
    int phase_lo, phase_hi;
};

typedef unsigned u32x4 __attribute__((ext_vector_type(4)));
#define OPQV(x) asm volatile("" : "+v"(x))
#define OPQS(x) asm volatile("" : "+s"(x))
#define PHASE_IDS                                                         \
    int traw_ = threadIdx.x;                                              \
    OPQV(traw_);                                                          \
    int tid = traw_ & 255;                                                \
    const int half_ = __builtin_amdgcn_readfirstlane(traw_ >> 8);         \
    int bid = blockIdx.x * 2 + half_;                                     \
    OPQS(bid);                                                            \
    int nblk = gridDim.x * 2;                                             \
    OPQS(nblk);                                                           \
    unsigned long long wz_ = 0ull;                                        \
    OPQS(wz_);                                                            \
    char* ws = p.ws + wz_;
#define PHASE_IDS_G                     \
    int tid = threadIdx.x;              \
    OPQV(tid);                          \
    int bid = blockIdx.x;               \
    OPQS(bid);                          \
    int nblk = gridDim.x;               \
    OPQS(nblk);                         \
    unsigned long long wz_ = 0ull;      \
    OPQS(wz_);                          \
    char* ws = p.ws + wz_;
__device__ __forceinline__ float bf2f(bf16_t b) { return __uint_as_float(((unsigned)b) << 16); }
typedef float fv2_t __attribute__((ext_vector_type(2)));
__device__ __forceinline__ unsigned pk2(float lo, float hi) {
    const fv2_t f = {lo, hi};
    const bfv2 b = __builtin_convertvector(f, bfv2);
    return __builtin_bit_cast(unsigned, b);
}
__device__ __forceinline__ bf16_t f2bf(float f) { return (bf16_t)(pk2(f, 0.f) & 0xffffu); }
__device__ __forceinline__ float bflo(unsigned u) { return __uint_as_float(u << 16); }
__device__ __forceinline__ float bfhi(unsigned u) { return __uint_as_float(u & 0xffff0000u); }
__device__ __forceinline__ float sigmoidf_(float x) { return __builtin_amdgcn_rcpf(1.f + __expf(-x)); }
__device__ __forceinline__ float wave_sum(float v) {
#pragma unroll
    for (int o = 32; o > 0; o >>= 1) v += __shfl_xor(v, o, 64);
    return v;
}

#define XB_TMO      128
#define XB_XCNT(j)  (256  + 64 * (j))
#define XB_XSUB(j)  (1280 + 64 * (j))
#define XB_XGEN(j)  (2304 + 64 * (j))
#define XB_TOP      3328
#define XB_TOPGEN   3392
#define XCD_BAR_WORDS 3456
#define XB_SPIN_CAP (1u << 18)
#define LAS __attribute__((address_space(3)))

__device__ __forceinline__ unsigned xb_ld(unsigned* p)              { return __hip_atomic_load(p, __ATOMIC_RELAXED, __HIP_MEMORY_SCOPE_AGENT); }
__device__ __forceinline__ unsigned xb_add(unsigned* p, unsigned v) { return __hip_atomic_fetch_add(p, v, __ATOMIC_RELAXED, __HIP_MEMORY_SCOPE_AGENT); }
__device__ __forceinline__ unsigned xb_xcc_id() { return (unsigned)__builtin_amdgcn_s_getreg((3 << 11) | 20) & 0xFu; }
#define XB_SPIN(cond, bar) do { unsigned _sp = 0; while (cond) { __builtin_amdgcn_s_sleep(1); \
    if ((++_sp & 255u) == 0u) { if (xb_ld(&(bar)[XB_TMO])) break; if (_sp > XB_SPIN_CAP) { atomicAdd(&(bar)[XB_TMO], 1u); break; } } } } while (0)

struct XcdBarrier {
    unsigned* bar; unsigned x;
    volatile LAS unsigned* st;
};

__device__ __forceinline__ XcdBarrier xcd_barrier_post(unsigned* bar, volatile LAS unsigned* st) {
    XcdBarrier b; b.bar = bar; b.x = xb_xcc_id(); b.st = st;
    if (threadIdx.x == 0) (void)xb_add(&bar[XB_XCNT(b.x)], 1u);
    return b;
}
__device__ __forceinline__ void xcd_barrier_complete(unsigned* bar, unsigned x, unsigned& nloc, unsigned& nx) {
    const unsigned G = gridDim.x * gridDim.y * gridDim.z;
    unsigned sum, cnt, mine, sp = 0u;
    for (;;) {
        sum = 0u; cnt = 0u; mine = 0u;
#pragma unroll
        for (unsigned j = 0; j < 16; ++j) { const unsigned c = xb_ld(&bar[XB_XCNT(j)]); sum += c; cnt += (c > 0u) ? 1u : 0u; mine = (j == x) ? c : mine; }
        if (sum == G) break;
        __builtin_amdgcn_s_sleep(1);
        if ((++sp & 255u) == 0u) { if (xb_ld(&bar[XB_TMO])) break; if (sp > XB_SPIN_CAP) { atomicAdd(&bar[XB_TMO], 1u); break; } }
    }
    nloc = mine > 0u ? mine : 1u; nx = cnt > 0u ? cnt : 1u;
}

__device__ __forceinline__ void xcd_barrier(const XcdBarrier& b) {
    asm volatile("s_waitcnt vmcnt(0)" ::: "memory");
    __syncthreads();
    if (threadIdx.x == 0) {
        unsigned* bar = b.bar;
        __builtin_amdgcn_s_waitcnt(0);
        unsigned nloc = b.st[0], nx = b.st[1];
        if (nloc == 0u) { xcd_barrier_complete(bar, b.x, nloc, nx); b.st[0] = nloc; b.st[1] = nx; }
        const unsigned old = xb_add(&bar[XB_XSUB(b.x)], 1u);
        const unsigned gen = old / nloc;
        if (old + 1u == (gen + 1u) * nloc) {
            __builtin_amdgcn_fence(__ATOMIC_RELEASE, "agent");
            asm volatile("s_waitcnt vmcnt(0)" ::: "memory");
            const unsigned og = xb_add(&bar[XB_TOP], 1u);
            const unsigned tg = og / nx;
            if (og + 1u == (tg + 1u) * nx) xb_add(&bar[XB_TOPGEN], 1u);
            else XB_SPIN(xb_ld(&bar[XB_TOPGEN]) == tg, bar);
            __builtin_amdgcn_fence(__ATOMIC_ACQUIRE, "agent");
            xb_add(&bar[XB_XGEN(b.x)], 1u);
            asm volatile("s_waitcnt vmcnt(0)" ::: "memory");
        } else {
            XB_SPIN(xb_ld(&bar[XB_XGEN(b.x)]) == gen, bar);
            __builtin_amdgcn_fence(__ATOMIC_ACQUIRE, "agent");
            asm volatile("s_waitcnt vmcnt(0)" ::: "memory");
        }
    }
    __syncthreads();
}

__device__ __forceinline__ int swz64(int row, int c) { return row * 128 + ((c ^ ((row >> 1) & 7)) << 4); }

template <class F, class G>
__device__ __forceinline__ void staged_store(const f32x16 (&acc)[2][4], char* st, int lane, const F& f, const G& g) {
    const int l31 = lane & 31, hh = lane >> 5;
#pragma unroll
    for (int mh = 0; mh < 2; ++mh) {
#pragma unroll
        for (int ni = 0; ni < 2; ++ni)
#pragma unroll
            for (int m2 = 0; m2 < 2; ++m2)
#pragma unroll
                for (int gq = 0; gq < 4; ++gq) {
                    const int mi = mh * 2 + m2;
                    float o0, o1, o2, o3;
                    f(ni * 32 + 8 * gq + 4 * hh, acc[ni][mi][4 * gq + 0], acc[ni][mi][4 * gq + 1], acc[ni][mi][4 * gq + 2], acc[ni][mi][4 * gq + 3], o0, o1, o2, o3);
                    uint2 v;
                    v.x = pk2(o0, o1);
                    v.y = pk2(o2, o3);
                    *(uint2*)(st + (m2 * 32 + l31) * 144 + (ni * 32 + 8 * gq + 4 * hh) * 2) = v;
                    __builtin_amdgcn_sched_barrier(0);
                }
#pragma unroll 4
        for (int j = 0; j < 8; ++j) {
            const int r = j * 8 + (lane >> 3);
            const u32x4 v = *(const u32x4*)(st + r * 144 + (lane & 7) * 16);
            g(mh * 64 + r, (lane & 7) * 8, v);
        }
    }
}

template <class Epi>
__device__ __forceinline__ void gemm_tile(const bf16_t* __restrict__ A, int lda, const bf16_t* __restrict__ Bt, int K, int pm, int pn,
                                          const Epi& epi, char* smem, const int tid, const bool preloaded, const char* nAbase, const char* nBbase) {
    const int lane = tid & 63, wid = tid >> 6, wm = wid & 1, wn = wid >> 1;
    const int l31 = lane & 31, hh = lane >> 5;
    f32x16 acc[2][4];
#pragma unroll
    for (int a = 0; a < 2; ++a)
#pragma unroll
        for (int b = 0; b < 4; ++b)
#pragma unroll
            for (int i = 0; i < 16; ++i) acc[a][b][i] = 0.f;
    const int row0 = tid >> 3, c0 = (tid & 7) ^ ((tid >> 4) & 7);
    const unsigned offA = (unsigned)(row0 * lda + c0 * 8) * 2u, offB = (unsigned)(row0 * K + c0 * 8) * 2u;
    const char* Abase = (const char*)(A + (size_t)(pm * 256) * lda);
    const char* Bbase = (const char*)(Bt + (size_t)(pn * 256) * K);
#define DMA_TILE(stage, k0)                                                                                                   \
    {                                                                                                                         \
        _Pragma("unroll") for (int i = 0; i < 4; ++i)                                                                         \
            __builtin_amdgcn_global_load_lds((const unsigned*)(Abase + (size_t)((i * 64) * lda + (k0)) * 2 + offA), (LAS unsigned*)(smem + (stage) * 65536 + (i * 512 + tid) * 16), 16, 0, 0);        \
        _Pragma("unroll") for (int i = 0; i < 4; ++i)                                                                         \
            __builtin_amdgcn_global_load_lds((const unsigned*)(Bbase + (size_t)((i * 64) * K + (k0)) * 2 + offB), (LAS unsigned*)(smem + (stage) * 65536 + 32768 + (i * 512 + tid) * 16), 16, 0, 0); \
    }
    if (!preloaded) { DMA_TILE(0, 0); }
    asm volatile("s_waitcnt vmcnt(0)" ::: "memory");
    __syncthreads();
    const int nk = K >> 6;
#define DMA_PIECE(stage, k0, q)                                                                                               \
    {                                                                                                                         \
        if ((q) < 4)                                                                                                          \
            __builtin_amdgcn_global_load_lds((const unsigned*)(Abase + (size_t)(((q) * 64) * lda + (k0)) * 2 + offA), (LAS unsigned*)(smem + (stage) * 65536 + ((q) * 512 + tid) * 16), 16, 0, 0); \
        else                                                                                                                  \
            __builtin_amdgcn_global_load_lds((const unsigned*)(Bbase + (size_t)((((q) - 4) * 64) * K + (k0)) * 2 + offB), (LAS unsigned*)(smem + (stage) * 65536 + 32768 + (((q) - 4) * 512 + tid) * 16), 16, 0, 0); \
    }
#pragma unroll 1
    for (int kt = 0; kt < nk; ++kt) {
        const bool more = kt + 1 < nk;
        const int nst = (kt + 1) & 1, nk0 = (kt + 1) * 64;
        const char* sa = smem + (kt & 1) * 65536;
        const char* sb = sa + 32768;
#pragma unroll
        for (int kk = 0; kk < 4; ++kk) {
            bf16x8 fa[2], fb[4];
#pragma unroll
            for (int ni = 0; ni < 2; ++ni) fa[ni] = *(const bf16x8*)(sb + swz64(wn * 64 + ni * 32 + l31, kk * 2 + hh));
#pragma unroll
            for (int mi = 0; mi < 4; ++mi) fb[mi] = *(const bf16x8*)(sa + swz64(wm * 128 + mi * 32 + l31, kk * 2 + hh));
            __builtin_amdgcn_s_setprio(1);
#pragma unroll
            for (int ni = 0; ni < 2; ++ni)
#pragma unroll
                for (int mi = 0; mi < 4; ++mi) acc[ni][mi] = __builtin_amdgcn_mfma_f32_32x32x16_bf16(fa[ni], fb[mi], acc[ni][mi], 0, 0, 0);
            __builtin_amdgcn_s_setprio(0);
            __builtin_amdgcn_sched_barrier(0);
            if (more) {
                if (kk == 0) { DMA_PIECE(nst, nk0, 0); DMA_PIECE(nst, nk0, 1); DMA_PIECE(nst, nk0, 2); }
                if (kk == 1) { DMA_PIECE(nst, nk0, 3); DMA_PIECE(nst, nk0, 4); DMA_PIECE(nst, nk0, 5); }
                if (kk == 2) { DMA_PIECE(nst, nk0, 6); DMA_PIECE(nst, nk0, 7); }
            }
            __builtin_amdgcn_sched_barrier(0);
        }
        asm volatile("s_waitcnt vmcnt(0)" ::: "memory");
        __syncthreads();
    }
#undef DMA_PIECE
#undef DMA_TILE
    if (nAbase) {
#pragma unroll
        for (int i = 0; i < 4; ++i)
            __builtin_amdgcn_global_load_lds((const unsigned*)(nAbase + (size_t)((i * 64) * lda) * 2 + offA), (LAS unsigned*)(smem + (i * 512 + tid) * 16), 16, 0, 0);
#pragma unroll
        for (int i = 0; i < 4; ++i)
            __builtin_amdgcn_global_load_lds((const unsigned*)(nBbase + (size_t)((i * 64) * K) * 2 + offB), (LAS unsigned*)(smem + 32768 + (i * 512 + tid) * 16), 16, 0, 0);
    }
    if constexpr (Epi::STAGED) {
        epi.run(acc, smem + 65536 + wid * 9216, lane, pm * 256 + wm * 128, pn * 256 + wn * 64);
        __syncthreads();
    } else {
#pragma unroll
        for (int ni = 0; ni < 2; ++ni)
#pragma unroll
            for (int mi = 0; mi < 4; ++mi)
#pragma unroll
                for (int g = 0; g < 4; ++g) {
                    const int m = pm * 256 + wm * 128 + mi * 32 + l31;
                    const int n0 = pn * 256 + wn * 64 + ni * 32 + 8 * g + 4 * hh;
                    epi(m, n0, acc[ni][mi][4 * g + 0], acc[ni][mi][4 * g + 1], acc[ni][mi][4 * g + 2], acc[ni][mi][4 * g + 3]);
                }
    }
}

__device__ __forceinline__ bool tile_map(int v, int nM, int nN, int& pm, int& pn) {
    const int SM = 8, SN = nN < 8 ? nN : 8, TS = SM * SN;
    const int xcd = v & 7, slot = v >> 3;
    const int q = slot / TS, r = slot - q * TS;
    const int nSM = (nM + SM - 1) / SM, nSN = (nN + SN - 1) / SN;
    const int Sg = q * 8 + xcd;
    if (Sg >= nSM * nSN) return false;
    const int sm = Sg / nSN, sn = Sg - sm * nSN;
    pm = sm * SM + (r % SM);
    pn = sn * SN + (r / SM);
    return pm < nM && pn < nN;
}
__device__ __forceinline__ int tile_total(int nM, int nN) {
    const int SN = nN < 8 ? nN : 8;
    const int nS = ((nM + 7) / 8) * ((nN + SN - 1) / SN);
    return ((nS + 7) / 8) * 8 * 8 * SN;
}

__device__ __forceinline__ void st_bf4(bf16_t* p, float a, float b, float c, float d) {
    uint2 v;
    v.x = pk2(a, b);
    v.y = pk2(c, d);
    *(uint2*)p = v;
}

#define SS_ARGS int c, float a0, float a1, float a2, float a3, float &o0, float &o1, float &o2, float &o3
#define SG_ARGS int r, int c8, u32x4 v
template <class F>
__device__ __forceinline__ void staged_store_dst(const f32x16 (&acc)[2][4], char* st, int lane, bf16_t* dst0, size_t ld, const F& f) {
    staged_store(acc, st, lane, f, [dst0, ld](SG_ARGS) { *(u32x4*)(dst0 + (size_t)r * ld + c8) = v; });
}
struct EpiProj {
    static constexpr bool STAGED = true;
    bf16_t* proj;
    const float* lb;
    const float* gkb;
    __device__ __forceinline__ void run(const f32x16 (&acc)[2][4], char* st, int lane, int mrow0, int nbase) const {
        bf16_t* row0 = proj + (size_t)mrow0 * PW;
        if (nbase < 1024 || (nbase >= 5120 && nbase < 5632)) {
            const int col = nbase < 1024 ? C_HQ + nbase : C_GQ + (nbase - 5120);
            staged_store_dst(acc, st, lane, row0 + col, PW, [](SS_ARGS) { const float s = 0.08838834764831845f; o0 = a0 * s; o1 = a1 * s; o2 = a2 * s; o3 = a3 * s; });
        } else if (nbase < 3072) {
            const int dir = nbase >= 2048, j = nbase - 1024 - dir * 1024;
            const float* lbp = lb + dir * 1024 + j;
            staged_store_dst(acc, st, lane, row0 + (dir ? C_HKB : C_HKF) + j, PW, [lbp](SS_ARGS) {
                const float4 l4 = *(const float4*)(lbp + c);
                o0 = (1.f - l4.x) * (1.f - sigmoidf_(a0)); o1 = (1.f - l4.y) * (1.f - sigmoidf_(a1));
                o2 = (1.f - l4.z) * (1.f - sigmoidf_(a2)); o3 = (1.f - l4.w) * (1.f - sigmoidf_(a3));
            });
            staged_store_dst(acc, st, lane, row0 + (dir ? C_HLB : C_HLF) + j, PW, [lbp](SS_ARGS) {
                asm volatile("" : "+v"(a0), "+v"(a1), "+v"(a2), "+v"(a3));
                const float4 l4 = *(const float4*)(lbp + c);
                o0 = __logf(l4.x + (1.f - l4.x) * sigmoidf_(a0)); o1 = __logf(l4.y + (1.f - l4.y) * sigmoidf_(a1));
                o2 = __logf(l4.z + (1.f - l4.z) * sigmoidf_(a2)); o3 = __logf(l4.w + (1.f - l4.w) * sigmoidf_(a3));
            });
        } else if (nbase < 4096 || (nbase >= 5632 && nbase < 7168)) {
            const int col = nbase < 4096 ? C_HV + (nbase - 3072) : (nbase < 6144 ? C_GK + (nbase - 5632) : C_GV + (nbase - 6144));
            staged_store_dst(acc, st, lane, row0 + col, PW, [](SS_ARGS) { o0 = a0; o1 = a1; o2 = a2; o3 = a3; });
        } else if (nbase < 5120 || (nbase >= 7168 && nbase < 8192)) {
            const int col = nbase < 5120 ? C_HSG + (nbase - 4096) : C_GSG + (nbase - 7168);
            staged_store_dst(acc, st, lane, row0 + col, PW,
                         [](SS_ARGS) { o0 = a0 * sigmoidf_(a0); o1 = a1 * sigmoidf_(a1); o2 = a2 * sigmoidf_(a2); o3 = a3 * sigmoidf_(a3); });
        } else if (nbase < 10240) {
            staged_store_dst(acc, st, lane, row0 + C_MH + (nbase - 8192), PW,
                         [](SS_ARGS) { o0 = sigmoidf_(a0); o1 = sigmoidf_(a1); o2 = sigmoidf_(a2); o3 = sigmoidf_(a3); });
        } else {
            const float* bp = gkb + (nbase - 10240);
            staged_store_dst(acc, st, lane, row0 + C_GLF + (nbase - 10240), PW, [bp](SS_ARGS) {
                const float4 b4 = *(const float4*)(bp + c);
                const float z0 = a0 + b4.x, z1 = a1 + b4.y, z2 = a2 + b4.z, z3 = a3 + b4.w;
                o0 = -(fmaxf(-z0, 0.f) + __logf(1.f + __expf(-fabsf(z0)))) * 0.0625f;
                o1 = -(fmaxf(-z1, 0.f) + __logf(1.f + __expf(-fabsf(z1)))) * 0.0625f;
                o2 = -(fmaxf(-z2, 0.f) + __logf(1.f + __expf(-fabsf(z2)))) * 0.0625f;
                o3 = -(fmaxf(-z3, 0.f) + __logf(1.f + __expf(-fabsf(z3)))) * 0.0625f;
            });
        }
    }
};
#define SS_RAW [](SS_ARGS) { o0 = a0; o1 = a1; o2 = a2; o3 = a3; }
struct EpiBr1 {
    static constexpr bool STAGED = true;
    const bf16_t* proj;
    bf16_t* y1;
    __device__ __forceinline__ void run(const f32x16 (&acc)[2][4], char* st, int lane, int mrow0, int nbase) const {
        const bf16_t* sp = proj + (size_t)mrow0 * PW + C_MH + nbase;
        bf16_t* dp = y1 + (size_t)mrow0 * 1024 + nbase;
        staged_store(acc, st, lane, SS_RAW, [sp, dp](SG_ARGS) {
            const u32x4 sv = *(const u32x4*)(sp + (size_t)r * PW + c8);
            u32x4 o;
#pragma unroll
            for (int i = 0; i < 4; ++i) o[i] = pk2(bflo(v[i]) * bflo(sv[i]), bfhi(v[i]) * bfhi(sv[i]));
            *(u32x4*)(dp + (size_t)r * 1024 + c8) = o;
        });
    }
};
struct EpiBr2 {
    static constexpr bool STAGED = true;
    const bf16_t* proj;
    const bf16_t* y1;
    bf16_t* y;
    __device__ __forceinline__ void run(const f32x16 (&acc)[2][4], char* st, int lane, int mrow0, int nbase) const {
        const bf16_t* sp = proj + (size_t)mrow0 * PW + C_MG + nbase;
        const bf16_t* yp = y1 + (size_t)mrow0 * 1024 + nbase;
        bf16_t* dp = y + (size_t)mrow0 * 1024 + nbase;
        staged_store(acc, st, lane, SS_RAW, [sp, yp, dp](SG_ARGS) {
            const u32x4 sv = *(const u32x4*)(sp + (size_t)r * PW + c8);
            const u32x4 pv = *(const u32x4*)(yp + (size_t)r * 1024 + c8);
            u32x4 o;
#pragma unroll
            for (int i = 0; i < 4; ++i) o[i] = pk2(bflo(pv[i]) + bflo(v[i]) * bflo(sv[i]), bfhi(pv[i]) + bfhi(v[i]) * bfhi(sv[i]));
            *(u32x4*)(dp + (size_t)r * 1024 + c8) = o;
        });
    }
};
struct EpiOut {
    static constexpr bool STAGED = true;
    const float* x;
    const float* mod;
    float* out;
    int row0;
    __device__ __forceinline__ void run(const f32x16 (&acc)[2][4], char* st, int lane, int mrow0, int nbase) const {
        const int grow0 = row0 + mrow0, b = grow0 >> 11;
        const float* xp = x + (size_t)grow0 * 1024 + nbase;
        const float* gp = mod + (size_t)b * NMOD + 2048 + nbase;
        float* dp = out + (size_t)grow0 * 1024 + nbase;
        staged_store(acc, st, lane, SS_RAW, [xp, gp, dp](SG_ARGS) {
            const float4 x0 = *(const float4*)(xp + (size_t)r * 1024 + c8), x1 = *(const float4*)(xp + (size_t)r * 1024 + c8 + 4);
            const float4 g0 = *(const float4*)(gp + c8), g1 = *(const float4*)(gp + c8 + 4);
            float4 o0, o1;
            o0.x = x0.x + g0.x * bflo(v[0]); o0.y = x0.y + g0.y * bfhi(v[0]); o0.z = x0.z + g0.z * bflo(v[1]); o0.w = x0.w + g0.w * bfhi(v[1]);
            o1.x = x1.x + g1.x * bflo(v[2]); o1.y = x1.y + g1.y * bfhi(v[2]); o1.z = x1.z + g1.z * bflo(v[3]); o1.w = x1.w + g1.w * bfhi(v[3]);
            *(float4*)(dp + (size_t)r * 1024 + c8) = o0;
            *(float4*)(dp + (size_t)r * 1024 + c8 + 4) = o1;
        });
    }
};
struct EpiQ {
    static constexpr bool STAGED = true;
    bf16_t* q;
    __device__ __forceinline__ void run(const f32x16 (&acc)[2][4], char* st, int lane, int mrow0, int nbase) const {
        staged_store_dst(acc, st, lane, q + (size_t)mrow0 * 2048 + nbase, 2048, SS_RAW);
    }
};

__device__ __forceinline__ void transpose_tile(const float* __restrict__ src, int lds_, int srccol0, int k0, bf16_t* __restrict__ dst  , char* smem, const int tid) {
    float* tile = (float*)smem;
    {
        const int r = tid >> 6, c = tid & 63;
#pragma unroll
        for (int p = 0; p < 16; ++p) {
            const int row = p * 4 + r;
            tile[row * 65 + c] = src[(size_t)(k0 + row) * lds_ + srccol0 + c];
        }
    }
    __syncthreads();
    {
        const int n = tid >> 2, ks = (tid & 3) * 16;
        float v[16];
#pragma unroll
        for (int i = 0; i < 16; ++i) v[i] = tile[(ks + i) * 65 + n];
        uint4 o0, o1;
        o0.x = pk2(v[0], v[1]); o0.y = pk2(v[2], v[3]); o0.z = pk2(v[4], v[5]); o0.w = pk2(v[6], v[7]);
        o1.x = pk2(v[8], v[9]); o1.y = pk2(v[10], v[11]); o1.z = pk2(v[12], v[13]); o1.w = pk2(v[14], v[15]);
        bf16_t* d = dst + (size_t)n * 1024 + k0 + ks;
        *(uint4*)d = o0;
        *(uint4*)(d + 8) = o1;
    }
    __syncthreads();
}

__device__ __forceinline__ void phase_prep(const Params& p, char* smem) {
    PHASE_IDS
    smem += half_ * HALF_SMEM;
    constexpr int N_TIN = 16 * 160, N_TBR = 256, N_TQ = 512, N_FOLD = 256, N_MODP = 24 * KSPL, N_CVK = 16, N_CVUV = 8192;
    constexpr int I0 = N_MODP, I1 = I0 + N_TIN, I2 = I1 + 3 * N_TBR, I3 = I2 + N_TQ, I4 = I3 + N_FOLD, I5 = I4 + N_CVK, I6 = I5 + N_CVUV;
    if (bid == 0) {
        float* lb = (float*)(ws + OFF_LB);
        for (int i = tid; i < 2048; i += 256) lb[i] = sigmoidf_(p.lb_logits[i] - p.lb_logits[2048 + i]);
    }
    for (int it = bid; it < I6; it += nblk) {
        if (it < I0) {
            const int cb = it / KSPL, ks = it % KSPL;
            float* s = (float*)smem;
            for (int i = tid; i < 33 * 128; i += 256) {
                const int b = i >> 7, k = i & 127;
                const float cv = (b < 32) ? p.c[b * 1024 + ks * 128 + k] : p.c_ctx[ks * 128 + k];
                s[i] = cv * sigmoidf_(cv);
            }
            __syncthreads();
            float acc[33];
#pragma unroll
            for (int b = 0; b < 33; ++b) acc[b] = 0.f;
            const int j = cb * 256 + tid;
            const float* wp = p.ada_w + (size_t)(ks * 128) * NMOD + j;
            for (int k = 0; k < 128; k += 4) {
                const float w0 = wp[(size_t)(k + 0) * NMOD], w1 = wp[(size_t)(k + 1) * NMOD], w2 = wp[(size_t)(k + 2) * NMOD], w3 = wp[(size_t)(k + 3) * NMOD];
#pragma unroll
                for (int b = 0; b < 33; ++b) {
                    const float4 sv = *(const float4*)(s + b * 128 + k);
                    acc[b] += sv.x * w0 + sv.y * w1 + sv.z * w2 + sv.w * w3;
                }
            }
            float* mp = (float*)(ws + OFF_MODP) + (size_t)ks * 33 * NMOD + j;
#pragma unroll
            for (int b = 0; b < 33; ++b) mp[(size_t)b * NMOD] = acc[b];
            __syncthreads();
        } else if (it < I1) {
            const int r = it - I0, nt = r % 160, kt = r / 160;
            const int n0 = nt * 64;
            const int src0 = n0 < 8192 ? n0 : n0 + 32;
            transpose_tile(p.w_in, DIN, src0, kt * 64, (bf16_t*)(ws + OFF_WIN) + (size_t)n0 * 1024, smem, tid);
        } else if (it < I2) {
            const int r = it - I1, which = r / N_TBR, rr = r % N_TBR, nt = rr % 16, kt = rr / 16;
            const float* src = which == 0 ? p.w_br_hg : (which == 1 ? p.w_br_gla : p.w_out);
            bf16_t* dst = (bf16_t*)(ws + (which == 0 ? OFF_WBRH : (which == 1 ? OFF_WBRG : OFF_WO)));
            transpose_tile(src, 1024, nt * 64, kt * 64, dst + (size_t)(nt * 64) * 1024, smem, tid);
        } else if (it < I3) {
            const int r = it - I2, nt = r % 32, kt = r / 32;
            transpose_tile(p.wq, 2048, nt * 64, kt * 64, (bf16_t*)(ws + OFF_WQ) + (size_t)(nt * 64) * 1024, smem, tid);
        } else if (it < I4) {
            const int r = it - I3, dir = r >> 7, nt = (r >> 4) & 7, kt = r & 15;
            float* sW = (float*)smem;
            float* sG = sW + 64 * 16;
            for (int i = tid; i < 1024; i += 256) {
                const int k = i >> 4, rr = i & 15;
                sW[i] = p.w_in[(size_t)(kt * 64 + k) * DIN + 8192 + 16 * dir + rr];
                const int r2 = i >> 6, n = i & 63;
                sG[i] = p.gk_w[(size_t)dir * 16 * 512 + r2 * 512 + nt * 64 + n];
            }
            __syncthreads();
            const int n = tid >> 2, ks = (tid & 3) * 16;
            float v[16];
#pragma unroll
            for (int i = 0; i < 16; ++i) {
                float a = 0.f;
#pragma unroll
                for (int rr = 0; rr < 16; ++rr) a += sW[(ks + i) * 16 + rr] * sG[rr * 64 + n];
                v[i] = a;
            }
            uint4 o0, o1;
            o0.x = pk2(v[0], v[1]); o0.y = pk2(v[2], v[3]); o0.z = pk2(v[4], v[5]); o0.w = pk2(v[6], v[7]);
            o1.x = pk2(v[8], v[9]); o1.y = pk2(v[10], v[11]); o1.z = pk2(v[12], v[13]); o1.w = pk2(v[14], v[15]);
            bf16_t* d = (bf16_t*)(ws + OFF_WIN) + (size_t)(10240 + dir * 512 + nt * 64 + n) * 1024 + kt * 64 + ks;
            *(uint4*)d = o0;
            *(uint4*)(d + 8) = o1;
            __syncthreads();
        } else if (it < I5) {
            const int r = it - I4;
            const float* src = r < 8 ? p.k1 : p.k2;
            bf16_t* dst = (bf16_t*)(ws + (r < 8 ? OFF_K1 : OFF_K2));
            const size_t e0 = (size_t)(r & 7) * 2048;
            const float4 a = *(const float4*)(src + e0 + tid * 8), b = *(const float4*)(src + e0 + tid * 8 + 4);
            uint4 o;
            o.x = pk2(a.x, a.y); o.y = pk2(a.z, a.w); o.z = pk2(b.x, b.y); o.w = pk2(b.z, b.w);
            *(uint4*)(dst + e0 + tid * 8) = o;
        } else {
            const int r = it - I5, isv = r >= 4096, row = (r & 4095) * 4 + (tid >> 6), lane = tid & 63;
            const float* src = (isv ? p.v : p.u) + (size_t)row * 1024 + lane * 16;
            float4 f[4];
            float am = 0.f;
#pragma unroll
            for (int i = 0; i < 4; ++i) {
                f[i] = *(const float4*)(src + i * 4);
                am = fmaxf(am, fmaxf(fmaxf(fabsf(f[i].x), fabsf(f[i].y)), fmaxf(fabsf(f[i].z), fabsf(f[i].w))));
            }
#pragma unroll
            for (int o = 32; o > 0; o >>= 1) am = fmaxf(am, __shfl_xor(am, o, 64));
            const float sc = am > 0.f ? 384.f / am : 1.f;
            int w4[4];
#pragma unroll
            for (int i = 0; i < 4; ++i) {
                int pk = 0;
                pk = __builtin_amdgcn_cvt_pk_fp8_f32(f[i].x * sc, f[i].y * sc, pk, false);
                pk = __builtin_amdgcn_cvt_pk_fp8_f32(f[i].z * sc, f[i].w * sc, pk, true);
                w4[i] = pk;
            }
            uint4 o;
            o.x = (unsigned)w4[0]; o.y = (unsigned)w4[1]; o.z = (unsigned)w4[2]; o.w = (unsigned)w4[3];
            if (isv) *(uint4*)(ws + OFF_V + (size_t)(lane >> 3) * (16384 * 128) + (size_t)row * 128 + (lane & 7) * 16) = o;
            else *(uint4*)(ws + OFF_U + (size_t)row * 1024 + lane * 16) = o;
            if (lane == 0) ((float*)(ws + (isv ? OFF_VS : OFF_US)))[row] = am > 0.f ? am * (1.f / 384.f) : 1.f;
        }
    }
}

__device__ __forceinline__ void phase_modreduce(const Params& p) {
    PHASE_IDS
    const float* mp = (const float*)(ws + OFF_MODP);
    float* mod = (float*)(ws + OFF_MOD);
    for (int i = bid * 256 + tid; i < 33 * NMOD; i += nblk * 256) {
        float a = p.ada_b[i % NMOD];
#pragma unroll
        for (int ks = 0; ks < KSPL; ++ks) a += mp[(size_t)ks * 33 * NMOD + i];
        mod[i] = a;
    }
}

__device__ __forceinline__ void norm_mod_rows4(const float* __restrict__ xr, const float* __restrict__ g, const float* __restrict__ shift,
                                               const float* __restrict__ scale, bf16_t* __restrict__ dst, int lane) {
    float4 v[4][4];
#pragma unroll
    for (int r = 0; r < 4; ++r)
#pragma unroll
        for (int i = 0; i < 4; ++i) v[r][i] = *(const float4*)(xr + (size_t)r * 1024 + i * 256 + lane * 4);
    float4 gv[4], sh[4], sc[4];
#pragma unroll
    for (int i = 0; i < 4; ++i) {
        const int c = i * 256 + lane * 4;
        gv[i] = *(const float4*)(g + c);
        sh[i] = *(const float4*)(shift + c);
        sc[i] = *(const float4*)(scale + c);
        gv[i].x *= 1.f + sc[i].x; gv[i].y *= 1.f + sc[i].y; gv[i].z *= 1.f + sc[i].z; gv[i].w *= 1.f + sc[i].w;
    }
#pragma unroll
    for (int r = 0; r < 4; ++r) {
        float ss = 0.f;
#pragma unroll
        for (int i = 0; i < 4; ++i) ss += v[r][i].x * v[r][i].x + v[r][i].y * v[r][i].y + v[r][i].z * v[r][i].z + v[r][i].w * v[r][i].w;
        ss = wave_sum(ss);
        const float rstd = rsqrtf(ss * (1.f / 1024.f) + EPS);
#pragma unroll
        for (int i = 0; i < 4; ++i) {
            const int c = i * 256 + lane * 4;
            st_bf4(dst + (size_t)r * 1024 + c, v[r][i].x * rstd * gv[i].x + sh[i].x, v[r][i].y * rstd * gv[i].y + sh[i].y,
                   v[r][i].z * rstd * gv[i].z + sh[i].z, v[r][i].w * rstd * gv[i].w + sh[i].w);
        }
    }
}

__device__ __forceinline__ void phase_hprep(const Params& p, int g) {
    PHASE_IDS
    const int lane = tid & 63, wv = bid * 4 + (tid >> 6), nwv = nblk * 4;
    const float* mod = (const float*)(ws + OFF_MOD);
    bf16_t* h = (bf16_t*)(ws + OFF_H);
    for (int lr = wv * 4; lr < GROWS; lr += nwv * 4) {
        const float* xr;
        int mb;
        if (lr < GLAT) {
            const int b = g * GB + (lr >> 11);
            xr = p.x + ((size_t)b * SEQ + (lr & 2047)) * 1024;
            mb = b;
        } else {
            const int l2 = lr - GLAT, b = g * GB + (l2 >> 8);
            xr = p.ctx + ((size_t)b * CTXL + (l2 & 255)) * 1024;
            mb = 32;
        }
        norm_mod_rows4(xr, p.norm_mix_g, mod + (size_t)mb * NMOD, mod + (size_t)mb * NMOD + 1024, h + (size_t)lr * 1024, lane);
    }
}

__device__ __forceinline__ void phase_h2(const Params& p) {
    PHASE_IDS
    const int lane = tid & 63, wv = bid * 4 + (tid >> 6), nwv = nblk * 4;
    const float* mod = (const float*)(ws + OFF_MOD);
    bf16_t* h2 = (bf16_t*)(ws + OFF_H2);
    for (int r = wv * 4; r < NTOK; r += nwv * 4) {
        const int b = r >> 11;
        norm_mod_rows4(p.out + (size_t)r * 1024, p.norm_ffn_g, mod + (size_t)b * NMOD + 3072, mod + (size_t)b * NMOD + 4096, h2 + (size_t)r * 1024, lane);
    }
}

template <class Skip>
__device__ __forceinline__ bool next_tile(int& v, int tot, int step, int nM, int nN, const Skip& skip, int& pm, int& pn) {
    while (v < tot) {
        if (tile_map(v, nM, nN, pm, pn) && !skip(pm, pn)) return true;
        v += step;
    }
    return false;
}

__device__ __forceinline__ void phase_gemm_in(const Params& p, char* smem) {
    PHASE_IDS_G
    EpiProj epi{(bf16_t*)(ws + OFF_PROJ), (const float*)(ws + OFF_LB), p.gk_b};
    const bf16_t* A = (const bf16_t*)(ws + OFF_H);
    const bf16_t* Bt = (const bf16_t*)(ws + OFF_WIN);
    constexpr int nM = GROWS / 256, nN = NW / 256;
    const int tot = tile_total(nM, nN);
    auto skip = [](int pm, int pn) {
        return pm >= GLAT / 256 && !((pn >= 4 && pn < 16) || (pn >= 22 && pn < 28) || (pn >= 40));
    };
    int v = bid, pm, pn;
    bool have = next_tile(v, tot, nblk, nM, nN, skip, pm, pn), pre = false;
    while (have) {
        int v2 = v + nblk, pm2 = 0, pn2 = 0;
        const bool have2 = next_tile(v2, tot, nblk, nM, nN, skip, pm2, pn2);
        gemm_tile(A, 1024, Bt, 1024, pm, pn, epi, smem, tid, pre, have2 ? (const char*)(A + (size_t)(pm2 * 256) * 1024) : nullptr,
                  have2 ? (const char*)(Bt + (size_t)(pn2 * 256) * 1024) : nullptr);
        pre = have2; have = have2; v = v2; pm = pm2; pn = pn2;
    }
}
__device__ __forceinline__ void phase_branch(const Params& p, char* smem) {
    PHASE_IDS_G
    const bf16_t* proj = (const bf16_t*)(ws + OFF_PROJ);
    bf16_t* y1 = (bf16_t*)(ws + OFF_Y1);
    EpiBr1 e1{proj, y1};
    EpiBr2 e2{proj, y1, (bf16_t*)(ws + OFF_Y)};
    const bf16_t* A1 = (const bf16_t*)(ws + OFF_YN);
    const bf16_t* A2 = A1 + (size_t)GLAT * 1024;
    constexpr int nM = GLAT / 256, nN = 4;
    const int tot = tile_total(nM, nN);
    auto skip = [](int, int) { return false; };
    const bf16_t* W1 = (const bf16_t*)(ws + OFF_WBRH);
    const bf16_t* W2 = (const bf16_t*)(ws + OFF_WBRG);
    int v = bid, pm, pn;
    bool have = next_tile(v, tot, nblk, nM, nN, skip, pm, pn), pre = false;
    while (have) {
        int v2 = v + nblk, pm2 = 0, pn2 = 0;
        const bool have2 = next_tile(v2, tot, nblk, nM, nN, skip, pm2, pn2);
        gemm_tile(A1, 1024, W1, 1024, pm, pn, e1, smem, tid, pre, (const char*)(A2 + (size_t)(pm * 256) * 1024), (const char*)(W2 + (size_t)(pn * 256) * 1024));
        gemm_tile(A2, 1024, W2, 1024, pm, pn, e2, smem, tid, true, have2 ? (const char*)(A1 + (size_t)(pm2 * 256) * 1024) : nullptr,
                  have2 ? (const char*)(W1 + (size_t)(pn2 * 256) * 1024) : nullptr);
        pre = have2; have = have2; v = v2; pm = pm2; pn = pn2;
    }
}
__device__ __forceinline__ void phase_outproj(const Params& p, int g, char* smem) {
    PHASE_IDS_G
    EpiOut e{p.x, (const float*)(ws + OFF_MOD), p.out, g * GLAT};
    constexpr int nM = GLAT / 256, nN = 4;
    const int tot = tile_total(nM, nN);
    auto skip = [](int, int) { return false; };
    const bf16_t* A = (const bf16_t*)(ws + OFF_Y);
    const bf16_t* Bt = (const bf16_t*)(ws + OFF_WO);
    int v = bid, pm, pn;
    bool have = next_tile(v, tot, nblk, nM, nN, skip, pm, pn), pre = false;
    while (have) {
        int v2 = v + nblk, pm2 = 0, pn2 = 0;
        const bool have2 = next_tile(v2, tot, nblk, nM, nN, skip, pm2, pn2);
        gemm_tile(A, 1024, Bt, 1024, pm, pn, e, smem, tid, pre, have2 ? (const char*)(A + (size_t)(pm2 * 256) * 1024) : nullptr,
                  have2 ? (const char*)(Bt + (size_t)(pn2 * 256) * 1024) : nullptr);
        pre = have2; have = have2; v = v2; pm = pm2; pn = pn2;
    }
}
__device__ __forceinline__ void phase_qproj(const Params& p, char* smem) {
    PHASE_IDS_G
    EpiQ e{(bf16_t*)(ws + OFF_Q)};
    constexpr int nM = NTOK / 256, nN = 8;
    const int tot = tile_total(nM, nN);
    auto skip = [](int, int) { return false; };
    const bf16_t* A = (const bf16_t*)(ws + OFF_H2);
    const bf16_t* Bt = (const bf16_t*)(ws + OFF_WQ);
    int v = bid, pm, pn;
    bool have = next_tile(v, tot, nblk, nM, nN, skip, pm, pn), pre = false;
    while (have) {
        int v2 = v + nblk, pm2 = 0, pn2 = 0;
        const bool have2 = next_tile(v2, tot, nblk, nM, nN, skip, pm2, pn2);
        gemm_tile(A, 1024, Bt, 1024, pm, pn, e, smem, tid, pre, have2 ? (const char*)(A + (size_t)(pm2 * 256) * 1024) : nullptr,
                  have2 ? (const char*)(Bt + (size_t)(pn2 * 256) * 1024) : nullptr);
        pre = have2; have = have2; v = v2; pm = pm2; pn = pn2;
    }
}

__device__ __forceinline__ int vtrow(int v) { return (v & ~7) | (((v & 7) + (v >> 3)) & 7); }
__device__ __forceinline__ int swz128(int row, int c16) { return row * 256 + ((c16 ^ (row & 15)) << 4); }

__device__ __forceinline__ void phase_scan(const Params& p, char* smem) {
    PHASE_IDS
    const bf16_t* proj = (const bf16_t*)(ws + OFF_PROJ);
    bf16_t* obase = (bf16_t*)(ws + OFF_O);
    const int lane = tid & 63, w = tid >> 6, l31 = lane & 31, hh = lane >> 5;
    char* sQ = smem;
    char* sK = smem + 16384;
    char* sS = smem + 32768;
    char* sKT = smem + 49152;
    char* sVT = smem + 67584;
    float* sTot = (float*)(smem + 76800);
    float* sF32 = sTot + 256;
    float* sEbr = sF32 + 128;
    float* sEbl = sEbr + 128;
    for (int it = bid; it < 512; it += nblk) {
        const int is_gla = it >> 8, r8 = it & 255;
        int vs, dir, hd, bl, cq, ck, cl, cv, co;
        if (!is_gla) {
            vs = r8 & 1; dir = (r8 >> 1) & 1; hd = (r8 >> 2) & 7; bl = r8 >> 5;
            cq = C_HQ + hd * 128; ck = (dir ? C_HKB : C_HKF) + hd * 128; cl = (dir ? C_HLB : C_HLF) + hd * 128;
            cv = C_HV + hd * 128 + vs * 64; co = hd * 128 + vs * 64;
        } else {
            vs = r8 & 3; dir = (r8 >> 2) & 1; hd = (r8 >> 3) & 3; bl = r8 >> 5;
            cq = C_GQ + hd * 128; ck = C_GK + hd * 128; cl = (dir ? C_GLB : C_GLF) + hd * 128;
            cv = C_GV + hd * 256 + vs * 64; co = hd * 256 + vs * 64;
        }
        bf16_t* odst = obase + (size_t)(is_gla * 2 + dir) * GLAT * 1024;
        f32x16 S[2];
#pragma unroll
        for (int a = 0; a < 2; ++a)
#pragma unroll
            for (int i = 0; i < 16; ++i) S[a][i] = 0.f;
        u32x4 rq[4], rk[4], rl[4], rv[2];
#define ROWOF(step, r) ((step) < 4 ? (GLAT + bl * 256 + (dir ? 255 - ((step) * 64 + (r)) : ((step) * 64 + (r)))) \
                                   : (bl * 2048 + (dir ? 2047 - (((step) - 4) * 64 + (r)) : (((step) - 4) * 64 + (r)))))
#define LOADCHUNK(step)                                                                   \
    {                                                                                     \
        _Pragma("unroll") for (int i = 0; i < 4; ++i) {                                   \
            const int id = tid + i * 256, r = id >> 4, c16 = id & 15;                     \
            const bf16_t* rp = proj + (size_t)ROWOF(step, r) * PW + c16 * 8;              \
            rq[i] = *(const u32x4*)(rp + ((step) >= 4 ? cq : ck));                        \
            rk[i] = *(const u32x4*)(rp + ck);                                             \
            rl[i] = *(const u32x4*)(rp + cl);                                             \
        }                                                                                 \
        _Pragma("unroll") for (int i = 0; i < 2; ++i) {                                   \
            const int id = tid + i * 256, r = id >> 3, c8 = id & 7;                       \
            rv[i] = *(const u32x4*)(proj + (size_t)ROWOF(step, r) * PW + cv + c8 * 8);    \
        }                                                                                 \
    }
        LOADCHUNK(0);
        for (int step = 0; step < 36; ++step) {
            const bool has_q = step >= 4;
#pragma unroll
            for (int i = 0; i < 4; ++i) {
                const int id = tid + i * 256, r = id >> 4, c16 = id & 15;
                const int off = swz128(r, c16);
                if (has_q) *(u32x4*)(sQ + off) = rq[i];
                *(u32x4*)(sK + off) = rk[i];
                *(u32x4*)(sS + off) = rl[i];
            }
#pragma unroll
            for (int i = 0; i < 2; ++i) {
                const int id = tid + i * 256, r = id >> 3, c8 = id & 7;
#pragma unroll
                for (int j = 0; j < 4; ++j) {
                    *(bf16_t*)(sVT + (c8 * 8 + ((2 * j + c8) & 7)) * 144 + r * 2) = (bf16_t)(rv[i][j] & 0xffffu);
                    *(bf16_t*)(sVT + (c8 * 8 + ((2 * j + 1 + c8) & 7)) * 144 + r * 2) = (bf16_t)(rv[i][j] >> 16);
                }
            }
            __syncthreads();
            if (step + 1 < 36) { LOADCHUNK(step + 1); }
            const int c = tid & 127, rh = tid >> 7;
            float lg[32];
            float tot = 0.f;
#pragma unroll
            for (int i = 0; i < 32; ++i) {
                const int r = 32 * rh + i;
                lg[i] = bf2f(*(const bf16_t*)(sS + swz128(r, c >> 3) + (c & 7) * 2));
                tot += lg[i];
            }
            sTot[rh * 128 + c] = tot;
            if (rh == 1) sF32[c] = lg[0];
            __syncthreads();
            {
                const float t0 = sTot[c], bref = t0 + sF32[c], blast = t0 + sTot[128 + c];
                float b = rh ? t0 : 0.f;
                if (rh == 0) {
                    sEbr[c] = __expf(bref);
                    sEbl[c] = __expf(blast - bref);
                }
#pragma unroll
                for (int j4 = 0; j4 < 4; ++j4) {
                    float kmv[8];
#pragma unroll
                    for (int jj = 0; jj < 8; ++jj) {
                        const int i = j4 * 8 + jj, r = 32 * rh + i;
                        b += lg[i];
                        const float e = __expf(b - bref);
                        const float rinv = __builtin_amdgcn_rcpf(e);
                        const int off = swz128(r, c >> 3) + (c & 7) * 2;
                        const float km = bf2f(*(const bf16_t*)(sK + off)) * rinv;
                        kmv[jj] = km;
                        *(bf16_t*)(sK + off) = f2bf(km);
                        if (has_q) {
                            const float qv = bf2f(*(const bf16_t*)(sQ + off));
                            *(bf16_t*)(sQ + off) = f2bf(qv * e);
                        }
                    }
                    uint4 o;
                    o.x = pk2(kmv[0], kmv[1]); o.y = pk2(kmv[2], kmv[3]); o.z = pk2(kmv[4], kmv[5]); o.w = pk2(kmv[6], kmv[7]);
                    *(uint4*)(sKT + c * 144 + (32 * rh + j4 * 8) * 2) = o;
                }
            }
            __syncthreads();
#pragma unroll
            for (int vt = 0; vt < 2; ++vt)
#pragma unroll
                for (int g4 = 0; g4 < 4; ++g4) {
                    const int c0 = 32 * w + 8 * g4 + 4 * hh;
                    const float4 eb = *(const float4*)(sEbr + c0);
                    S[vt][4 * g4 + 0] *= eb.x; S[vt][4 * g4 + 1] *= eb.y; S[vt][4 * g4 + 2] *= eb.z; S[vt][4 * g4 + 3] *= eb.w;
                    if (has_q) {
                        const int vrow = 32 * vt + l31;
                        uint2 o;
                        o.x = pk2(S[vt][4 * g4 + 0], S[vt][4 * g4 + 1]);
                        o.y = pk2(S[vt][4 * g4 + 2], S[vt][4 * g4 + 3]);
                        *(uint2*)(sS + swz128(vrow, c0 >> 3) + (c0 & 7) * 2) = o;
                    }
                }
            if (has_q) {
                const int st = w >> 1, rt = w & 1;
                f32x16 sc;
#pragma unroll
                for (int i = 0; i < 16; ++i) sc[i] = 0.f;
#pragma unroll
                for (int kk = 0; kk < 8; ++kk) {
                    const bf16x8 a = *(const bf16x8*)(sK + swz128(32 * st + l31, kk * 2 + hh));
                    const bf16x8 bq = *(const bf16x8*)(sQ + swz128(32 * rt + l31, kk * 2 + hh));
                    sc = __builtin_amdgcn_mfma_f32_32x32x16_bf16(a, bq, sc, 0, 0, 0);
                }
                __syncthreads();
                {
                    const int r = 32 * rt + l31;
#pragma unroll
                    for (int g4 = 0; g4 < 4; ++g4) {
                        const int s0 = 32 * st + 8 * g4 + 4 * hh;
                        uint2 o;
                        o.x = pk2(r >= s0 + 0 ? sc[4 * g4 + 0] : 0.f, r >= s0 + 1 ? sc[4 * g4 + 1] : 0.f);
                        o.y = pk2(r >= s0 + 2 ? sc[4 * g4 + 2] : 0.f, r >= s0 + 3 ? sc[4 * g4 + 3] : 0.f);
                        *(uint2*)(sK + r * 144 + s0 * 2) = o;
                    }
                }
                __syncthreads();
                {
                    const int vt = w >> 1, rt2 = w & 1;
                    f32x16 oa;
#pragma unroll
                    for (int i = 0; i < 16; ++i) oa[i] = 0.f;
#pragma unroll
                    for (int kk = 0; kk < 4; ++kk) {
                        const bf16x8 a = *(const bf16x8*)(sVT + vtrow(32 * vt + l31) * 144 + (kk * 2 + hh) * 16);
                        const bf16x8 bp = *(const bf16x8*)(sK + (32 * rt2 + l31) * 144 + (kk * 2 + hh) * 16);
                        oa = __builtin_amdgcn_mfma_f32_32x32x16_bf16(a, bp, oa, 0, 0, 0);
                    }
#pragma unroll
                    for (int kk = 0; kk < 8; ++kk) {
                        const bf16x8 a = *(const bf16x8*)(sS + swz128(32 * vt + l31, kk * 2 + hh));
                        const bf16x8 bq = *(const bf16x8*)(sQ + swz128(32 * rt2 + l31, kk * 2 + hh));
                        oa = __builtin_amdgcn_mfma_f32_32x32x16_bf16(a, bq, oa, 0, 0, 0);
                    }
                    const int r = 32 * rt2 + l31;
                    bf16_t* orow = odst + (size_t)ROWOF(step, r) * 1024 + co + 32 * vt + 4 * hh;
#pragma unroll
                    for (int g4 = 0; g4 < 4; ++g4) st_bf4(orow + 8 * g4, oa[4 * g4 + 0], oa[4 * g4 + 1], oa[4 * g4 + 2], oa[4 * g4 + 3]);
                }
            }
#pragma unroll
            for (int vt = 0; vt < 2; ++vt) {
#pragma unroll
                for (int kk = 0; kk < 4; ++kk) {
                    const bf16x8 a = *(const bf16x8*)(sKT + (32 * w + l31) * 144 + (kk * 2 + hh) * 16);
                    const bf16x8 bv = *(const bf16x8*)(sVT + vtrow(32 * vt + l31) * 144 + (kk * 2 + hh) * 16);
                    S[vt] = __builtin_amdgcn_mfma_f32_32x32x16_bf16(a, bv, S[vt], 0, 0, 0);
                }
#pragma unroll
                for (int g4 = 0; g4 < 4; ++g4) {
                    const int c0 = 32 * w + 8 * g4 + 4 * hh;
                    const float4 eb = *(const float4*)(sEbl + c0);
                    S[vt][4 * g4 + 0] *= eb.x; S[vt][4 * g4 + 1] *= eb.y; S[vt][4 * g4 + 2] *= eb.z; S[vt][4 * g4 + 3] *= eb.w;
                }
            }
            __syncthreads();
        }
#undef LOADCHUNK
#undef ROWOF
    }
}

__device__ __forceinline__ void phase_scan2(const Params& p, char* smem) {
    PHASE_IDS_G
    const bf16_t* proj = (const bf16_t*)(ws + OFF_PROJ);
    bf16_t* obase = (bf16_t*)(ws + OFF_O);
    const int lane = tid & 63, w = tid >> 6, l31 = lane & 31, hh = lane >> 5;
    char* sQ = smem;
    char* sK = smem + 16384;
    char* sL = smem + 32768;
    char* sS = smem + 49152;
    char* sKT = smem + 81920;
    char* sVT = smem + 100352;
    float* sTot = (float*)(smem + 118784);
    float* sF32 = sTot + 512;
    float* sEbr = sF32 + 128;
    float* sEbl = sEbr + 128;
    char* sP = smem + 122368;
    for (int it = bid; it < 256; it += nblk) {
        const int is_gla = it >> 7, r7 = it & 127;
        int dir, hd, bl, cq, ck, cl, cv, co;
        if (!is_gla) {
            dir = r7 & 1; hd = (r7 >> 1) & 7; bl = r7 >> 4;
            cq = C_HQ + hd * 128; ck = (dir ? C_HKB : C_HKF) + hd * 128; cl = (dir ? C_HLB : C_HLF) + hd * 128;
            cv = C_HV + hd * 128; co = hd * 128;
        } else {
            const int vs = r7 & 1;
            dir = (r7 >> 1) & 1; hd = (r7 >> 2) & 3; bl = r7 >> 4;
            cq = C_GQ + hd * 128; ck = C_GK + hd * 128; cl = (dir ? C_GLB : C_GLF) + hd * 128;
            cv = C_GV + hd * 256 + vs * 128; co = hd * 256 + vs * 128;
        }
        bf16_t* odst = obase + (size_t)(is_gla * 2 + dir) * GLAT * 1024;
        const int ct = w & 3, vh = w >> 2;
        f32x16 S[2];
#pragma unroll
        for (int a = 0; a < 2; ++a)
#pragma unroll
            for (int i = 0; i < 16; ++i) S[a][i] = 0.f;
        u32x4 rq[2], rk[2], rl[2], rv[2];
#define ROWOF(step, r) ((step) < 4 ? (GLAT + bl * 256 + (dir ? 255 - ((step) * 64 + (r)) : ((step) * 64 + (r)))) \
                                   : (bl * 2048 + (dir ? 2047 - (((step) - 4) * 64 + (r)) : (((step) - 4) * 64 + (r)))))
#define LOADCHUNK(step)                                                                   \
    {                                                                                     \
        _Pragma("unroll") for (int i = 0; i < 2; ++i) {                                   \
            const int id = tid + i * 512, r = id >> 4, c16 = id & 15;                     \
            const bf16_t* rp = proj + (size_t)ROWOF(step, r) * PW + c16 * 8;              \
            rq[i] = *(const u32x4*)(rp + ((step) >= 4 ? cq : ck));                        \
            rk[i] = *(const u32x4*)(rp + ck);                                             \
            rl[i] = *(const u32x4*)(rp + cl);                                             \
            rv[i] = *(const u32x4*)(rp + cv);                                             \
        }                                                                                 \
    }
        LOADCHUNK(0);
        for (int step = 0; step < 36; ++step) {
            const bool has_q = step >= 4;
#pragma unroll
            for (int i = 0; i < 2; ++i) {
                const int id = tid + i * 512, r = id >> 4, c16 = id & 15;
                const int off = swz128(r, c16);
                if (has_q) *(u32x4*)(sQ + off) = rq[i];
                *(u32x4*)(sK + off) = rk[i];
                *(u32x4*)(sL + off) = rl[i];
#pragma unroll
                for (int j = 0; j < 4; ++j) {
                    *(bf16_t*)(sVT + (c16 * 8 + ((2 * j + c16) & 7)) * 144 + r * 2) = (bf16_t)(rv[i][j] & 0xffffu);
                    *(bf16_t*)(sVT + (c16 * 8 + ((2 * j + 1 + c16) & 7)) * 144 + r * 2) = (bf16_t)(rv[i][j] >> 16);
                }
            }
            __syncthreads();
            if (step + 1 < 36) { LOADCHUNK(step + 1); }
            const int c = tid & 127, rg = tid >> 7;
            float lg[16];
            float tot = 0.f;
#pragma unroll
            for (int i = 0; i < 16; ++i) {
                const int r = 16 * rg + i;
                lg[i] = bf2f(*(const bf16_t*)(sL + swz128(r, c >> 3) + (c & 7) * 2));
                tot += lg[i];
            }
            sTot[rg * 128 + c] = tot;
            if (rg == 2) sF32[c] = lg[0];
            __syncthreads();
            {
                const float t0 = sTot[c], t1 = sTot[128 + c], t2 = sTot[256 + c], t3 = sTot[384 + c];
                const float bref = t0 + t1 + sF32[c], blast = t0 + t1 + t2 + t3;
                float b = (rg > 0 ? t0 : 0.f) + (rg > 1 ? t1 : 0.f) + (rg > 2 ? t2 : 0.f);
                if (rg == 0) {
                    sEbr[c] = __expf(bref);
                    sEbl[c] = __expf(blast - bref);
                }
#pragma unroll
                for (int j4 = 0; j4 < 2; ++j4) {
                    float kmv[8];
#pragma unroll
                    for (int jj = 0; jj < 8; ++jj) {
                        const int i = j4 * 8 + jj, r = 16 * rg + i;
                        b += lg[i];
                        const float e = __expf(b - bref);
                        const float rinv = __builtin_amdgcn_rcpf(e);
                        const int off = swz128(r, c >> 3) + (c & 7) * 2;
                        const float km = bf2f(*(const bf16_t*)(sK + off)) * rinv;
                        kmv[jj] = km;
                        *(bf16_t*)(sK + off) = f2bf(km);
                        if (has_q) {
                            const float qv = bf2f(*(const bf16_t*)(sQ + off));
                            *(bf16_t*)(sQ + off) = f2bf(qv * e);
                        }
                    }
                    uint4 o;
                    o.x = pk2(kmv[0], kmv[1]); o.y = pk2(kmv[2], kmv[3]); o.z = pk2(kmv[4], kmv[5]); o.w = pk2(kmv[6], kmv[7]);
                    *(uint4*)(sKT + c * 144 + (16 * rg + j4 * 8) * 2) = o;
                }
            }
            __syncthreads();
#pragma unroll
            for (int vt = 0; vt < 2; ++vt)
#pragma unroll
                for (int g4 = 0; g4 < 4; ++g4) {
                    const int c0 = 32 * ct + 8 * g4 + 4 * hh;
                    const float4 eb = *(const float4*)(sEbr + c0);
                    S[vt][4 * g4 + 0] *= eb.x; S[vt][4 * g4 + 1] *= eb.y; S[vt][4 * g4 + 2] *= eb.z; S[vt][4 * g4 + 3] *= eb.w;
                    if (has_q) {
                        const int vrow = 64 * vh + 32 * vt + l31;
                        uint2 o;
                        o.x = pk2(S[vt][4 * g4 + 0], S[vt][4 * g4 + 1]);
                        o.y = pk2(S[vt][4 * g4 + 2], S[vt][4 * g4 + 3]);
                        *(uint2*)(sS + swz128(vrow, c0 >> 3) + (c0 & 7) * 2) = o;
                    }
                }
            if (has_q) {
                f32x16 sc;
#pragma unroll
                for (int i = 0; i < 16; ++i) sc[i] = 0.f;
                const int st = (w >> 1) & 1, rt = w & 1;
                if (w < 4) {
#pragma unroll
                    for (int kk = 0; kk < 8; ++kk) {
                        const bf16x8 a = *(const bf16x8*)(sK + swz128(32 * st + l31, kk * 2 + hh));
                        const bf16x8 bq = *(const bf16x8*)(sQ + swz128(32 * rt + l31, kk * 2 + hh));
                        sc = __builtin_amdgcn_mfma_f32_32x32x16_bf16(a, bq, sc, 0, 0, 0);
                    }
                }
                if (w < 4) {
                    const int r = 32 * rt + l31;
#pragma unroll
                    for (int g4 = 0; g4 < 4; ++g4) {
                        const int s0 = 32 * st + 8 * g4 + 4 * hh;
                        uint2 o;
                        o.x = pk2(r >= s0 + 0 ? sc[4 * g4 + 0] : 0.f, r >= s0 + 1 ? sc[4 * g4 + 1] : 0.f);
                        o.y = pk2(r >= s0 + 2 ? sc[4 * g4 + 2] : 0.f, r >= s0 + 3 ? sc[4 * g4 + 3] : 0.f);
                        *(uint2*)(sP + r * 144 + s0 * 2) = o;
                    }
                }
                __syncthreads();
                {
                    const int vt4 = w >> 1, rt2 = w & 1;
                    f32x16 oa;
#pragma unroll
                    for (int i = 0; i < 16; ++i) oa[i] = 0.f;
#pragma unroll
                    for (int kk = 0; kk < 4; ++kk) {
                        const bf16x8 a = *(const bf16x8*)(sVT + vtrow(32 * vt4 + l31) * 144 + (kk * 2 + hh) * 16);
                        const bf16x8 bp = *(const bf16x8*)(sP + (32 * rt2 + l31) * 144 + (kk * 2 + hh) * 16);
                        oa = __builtin_amdgcn_mfma_f32_32x32x16_bf16(a, bp, oa, 0, 0, 0);
                    }
#pragma unroll
                    for (int kk = 0; kk < 8; ++kk) {
                        const bf16x8 a = *(const bf16x8*)(sS + swz128(32 * vt4 + l31, kk * 2 + hh));
                        const bf16x8 bq = *(const bf16x8*)(sQ + swz128(32 * rt2 + l31, kk * 2 + hh));
                        oa = __builtin_amdgcn_mfma_f32_32x32x16_bf16(a, bq, oa, 0, 0, 0);
                    }
                    const int r = 32 * rt2 + l31;
                    bf16_t* orow = odst + (size_t)ROWOF(step, r) * 1024 + co + 32 * vt4 + 4 * hh;
#pragma unroll
                    for (int g4 = 0; g4 < 4; ++g4) st_bf4(orow + 8 * g4, oa[4 * g4 + 0], oa[4 * g4 + 1], oa[4 * g4 + 2], oa[4 * g4 + 3]);
                }
            }
#pragma unroll
            for (int vt = 0; vt < 2; ++vt) {
#pragma unroll
                for (int kk = 0; kk < 4; ++kk) {
                    const bf16x8 a = *(const bf16x8*)(sKT + (32 * ct + l31) * 144 + (kk * 2 + hh) * 16);
                    const bf16x8 bv = *(const bf16x8*)(sVT + vtrow(64 * vh + 32 * vt + l31) * 144 + (kk * 2 + hh) * 16);
                    S[vt] = __builtin_amdgcn_mfma_f32_32x32x16_bf16(a, bv, S[vt], 0, 0, 0);
                }
#pragma unroll
                for (int g4 = 0; g4 < 4; ++g4) {
                    const int c0 = 32 * ct + 8 * g4 + 4 * hh;
                    const float4 eb = *(const float4*)(sEbl + c0);
                    S[vt][4 * g4 + 0] *= eb.x; S[vt][4 * g4 + 1] *= eb.y; S[vt][4 * g4 + 2] *= eb.z; S[vt][4 * g4 + 3] *= eb.w;
                }
            }
            __syncthreads();
        }
#undef LOADCHUNK
#undef ROWOF
    }
}

__device__ __forceinline__ void phase_headnorm(const Params& p) {
    PHASE_IDS
    const int lane = tid & 63, wv = bid * 4 + (tid >> 6), nwv = nblk * 4;
    const bf16_t* proj = (const bf16_t*)(ws + OFF_PROJ);
    const bf16_t* ob = (const bf16_t*)(ws + OFF_O);
    bf16_t* yn = (bf16_t*)(ws + OFF_YN);
    constexpr int R = 4;
    for (int job = wv * R; job < 2 * GLAT; job += nwv * R) {
        const int gla = job >= GLAT, lr0 = job - gla * GLAT;
        const float* gp = (gla ? p.gla_norm_g : p.hg_norm_g) + ((lane * 16) & (gla ? 255 : 127));
        u32x4 a[R][2], bq[R][2], sq[R][2];
#pragma unroll
        for (int r = 0; r < R; ++r) {
            const bf16_t* of = ob + (size_t)(gla * 2) * GLAT * 1024 + (size_t)(lr0 + r) * 1024 + lane * 16;
            const bf16_t* obw = of + (size_t)GLAT * 1024;
            const bf16_t* sgp = proj + (size_t)(lr0 + r) * PW + (gla ? C_GSG : C_HSG) + lane * 16;
#pragma unroll
            for (int hblk = 0; hblk < 2; ++hblk) {
                a[r][hblk] = *(const u32x4*)(of + hblk * 8);
                bq[r][hblk] = *(const u32x4*)(obw + hblk * 8);
                sq[r][hblk] = *(const u32x4*)(sgp + hblk * 8);
            }
        }
        float gf[16];
#pragma unroll
        for (int i = 0; i < 16; ++i) gf[i] = gp[i];
#pragma unroll
        for (int r = 0; r < R; ++r) {
            float o[16], sg[16];
#pragma unroll
            for (int hblk = 0; hblk < 2; ++hblk)
#pragma unroll
                for (int j = 0; j < 4; ++j) {
                    o[hblk * 8 + 2 * j] = bflo(a[r][hblk][j]) + bflo(bq[r][hblk][j]);
                    o[hblk * 8 + 2 * j + 1] = bfhi(a[r][hblk][j]) + bfhi(bq[r][hblk][j]);
                    sg[hblk * 8 + 2 * j] = bflo(sq[r][hblk][j]);
                    sg[hblk * 8 + 2 * j + 1] = bfhi(sq[r][hblk][j]);
                }
            float ss = 0.f;
#pragma unroll
            for (int i = 0; i < 16; ++i) ss += o[i] * o[i];
            ss += __shfl_xor(ss, 1, 64);
            ss += __shfl_xor(ss, 2, 64);
            ss += __shfl_xor(ss, 4, 64);
            if (gla) ss += __shfl_xor(ss, 8, 64);
            const float rstd = rsqrtf(ss * (gla ? (1.f / 256.f) : (1.f / 128.f)) + EPS);
            float y[16];
#pragma unroll
            for (int i = 0; i < 16; ++i) y[i] = o[i] * rstd * gf[i] * sg[i];
            bf16_t* d = yn + (size_t)gla * GLAT * 1024 + (size_t)(lr0 + r) * 1024 + lane * 16;
            uint4 o0, o1;
            o0.x = pk2(y[0], y[1]); o0.y = pk2(y[2], y[3]); o0.z = pk2(y[4], y[5]); o0.w = pk2(y[6], y[7]);
            o1.x = pk2(y[8], y[9]); o1.y = pk2(y[10], y[11]); o1.z = pk2(y[12], y[13]); o1.w = pk2(y[14], y[15]);
            *(uint4*)d = o0;
            *(uint4*)(d + 8) = o1;
        }
    }
}

__device__ __forceinline__ unsigned f2key(float f) {
    const unsigned u = __float_as_uint(f);
    return u ^ ((u >> 31) ? 0xffffffffu : 0x80000000u);
}
__device__ __forceinline__ float key2f(unsigned k) {
    const unsigned u = (k >> 31) ? (k ^ 0x80000000u) : ~k;
    return __uint_as_float(u);
}
#define TOPK_INSERT(arr, x)                        \
    {                                              \
        unsigned x_ = (x);                         \
        _Pragma("unroll") for (int q_ = 0; q_ < 16; ++q_) { \
            const unsigned hi_ = max(arr[q_], x_); \
            x_ = min(arr[q_], x_);                 \
            arr[q_] = hi_;                         \
        }                                          \
    }

template <int N>
__device__ __forceinline__ void bitonic_sort_desc(unsigned (&a)[N], const int base) {
#pragma unroll
    for (int k = 2; k <= 16; k <<= 1)
#pragma unroll
        for (int j = k >> 1; j > 0; j >>= 1)
#pragma unroll
            for (int i = 0; i < 16; ++i) {
                const int l = i ^ j;
                if (l > i) {
                    const bool desc = ((i & k) == 0);
                    const unsigned hi = max(a[base + i], a[base + l]), lo = min(a[base + i], a[base + l]);
                    a[base + i] = desc ? hi : lo;
                    a[base + l] = desc ? lo : hi;
                }
            }
}
template <int N, int M>
__device__ __forceinline__ void merge_top16(unsigned (&a)[N], const int ba, const unsigned (&b)[M], const int bb) {
#pragma unroll
    for (int i = 0; i < 16; ++i) a[ba + i] = max(a[ba + i], b[bb + 15 - i]);
#pragma unroll
    for (int j = 8; j > 0; j >>= 1)
#pragma unroll
        for (int i = 0; i < 16; ++i) {
            const int l = i ^ j;
            if (l > i) {
                const unsigned hi = max(a[ba + i], a[ba + l]), lo = min(a[ba + i], a[ba + l]);
                a[ba + i] = hi;
                a[ba + l] = lo;
            }
        }
}
__device__ __forceinline__ void top16_of_64(unsigned (&k)[64]) {
    bitonic_sort_desc(k, 0);
    bitonic_sort_desc(k, 16);
    bitonic_sort_desc(k, 32);
    bitonic_sort_desc(k, 48);
    merge_top16(k, 0, k, 16);
    merge_top16(k, 32, k, 48);
    merge_top16(k, 0, k, 32);
}

__device__ __forceinline__ void phase_topk(const Params& p, char* smem) {
    PHASE_IDS
    smem += half_ * HALF_SMEM;
    const bf16_t* q = (const bf16_t*)(ws + OFF_Q);
    const bf16_t* k1 = (const bf16_t*)(ws + OFF_K1);
    const bf16_t* k2 = (const bf16_t*)(ws + OFF_K2);
    int* sidx = (int*)(ws + OFF_SIDX);
    float* sgate = (float*)(ws + OFF_SGATE);
    float* sc = (float*)smem;
    unsigned* sM = (unsigned*)(smem + 128 * 130 * 4);
    const int lane = tid & 63, w = tid >> 6, l31 = lane & 31, hh = lane >> 5;
    for (int it = bid; it < 8192; it += nblk) {
        const int tb = it >> 3, hd = it & 7;
        {
            const int side = w >> 1, th = w & 1;
            const bf16_t* qrow = q + (size_t)(tb * 64 + th * 32 + l31) * 2048 + hd * 256 + side * 128 + 8 * hh;
            const bf16_t* kb = (side ? k2 : k1) + (size_t)l31 * 128 + 8 * hh;
            bf16x8 fa[8];
#pragma unroll
            for (int kk = 0; kk < 8; ++kk) fa[kk] = *(const bf16x8*)(qrow + kk * 16);
#pragma unroll
            for (int nt = 0; nt < 4; ++nt) {
                f32x16 acc;
#pragma unroll
                for (int i = 0; i < 16; ++i) acc[i] = 0.f;
                bf16x8 fb[8];
#pragma unroll
                for (int kk = 0; kk < 8; ++kk) fb[kk] = *(const bf16x8*)(kb + (size_t)(nt * 32) * 128 + kk * 16);
                __builtin_amdgcn_sched_barrier(0);
#pragma unroll
                for (int kk = 0; kk < 8; ++kk) acc = __builtin_amdgcn_mfma_f32_32x32x16_bf16(fa[kk], fb[kk], acc, 0, 0, 0);
                const int key = nt * 32 + l31;
                const int kpos = (key >> 6) * 65 + (key & 63);
#pragma unroll
                for (int i = 0; i < 16; ++i) {
                    const int tok = th * 32 + (i & 3) + 8 * (i >> 2) + 4 * hh;
                    sc[(side * 64 + tok) * 130 + kpos] = acc[i];
                }
            }
        }
        __syncthreads();
        unsigned a[64];
        {
            const int row = tid >> 1, half = tid & 1;
            const float* sp = sc + row * 130 + half * 65;
#pragma unroll
            for (int j = 0; j < 64; ++j) a[j] = (f2key(sp[j]) & ~127u) | (unsigned)(127 - (half * 64 + j));
            top16_of_64(a);
            if (half) {
#pragma unroll
                for (int i = 0; i < 16; ++i) sM[row * 16 + i] = a[i];
            }
        }
        __syncthreads();
        if (!(tid & 1)) {
            const int row = tid >> 1;
            unsigned b[16];
#pragma unroll
            for (int i = 0; i < 16; ++i) b[i] = sM[row * 16 + i];
            merge_top16(a, 0, b, 0);
        }
        __syncthreads();
        if (!(tid & 1)) {
            const int row = tid >> 1;
#pragma unroll
            for (int i = 0; i < 16; ++i) sM[row * 16 + i] = a[i];
        }
        __syncthreads();
        if (tid < 64) {
            const int t = tid;
            float v1[16], v2[16];
#pragma unroll
            for (int i = 0; i < 16; ++i) {
                v1[i] = key2f(sM[t * 16 + i] & ~127u);
                v2[i] = key2f(sM[(64 + t) * 16 + i] & ~127u);
            }
            unsigned cnd[64];
            {
                int n = 0;
#pragma unroll
                for (int i = 0; i < 16; ++i)
#pragma unroll
                    for (int j = 0; j < 16; ++j)
                        if ((i + 1) * (j + 1) <= 16) {
                            cnd[n] = (f2key(v1[i] + v2[j]) & ~255u) | (unsigned)(255 - (i * 16 + j));
                            ++n;
                        }
#pragma unroll
                for (int q = 50; q < 64; ++q) cnd[q] = 0u;
            }
            top16_of_64(cnd);
            float sv[16], mx, sum = 0.f;
            mx = key2f(cnd[0] & ~255u);
#pragma unroll
            for (int i = 0; i < 16; ++i) {
                sv[i] = __expf(key2f(cnd[i] & ~255u) - mx);
                sum += sv[i];
            }
            const float inv = 1.f / sum;
            const size_t ob = (size_t)(tb * 64 + t) * 128 + hd * 16;
#pragma unroll
            for (int i = 0; i < 16; ++i) {
                const int code = 255 - (int)(cnd[i] & 255u);
                const int i1 = 127 - (int)(sM[t * 16 + (code >> 4)] & 127u);
                const int i2 = 127 - (int)(sM[(64 + t) * 16 + (code & 15)] & 127u);
                sidx[ob + i] = i1 * 128 + i2;
                sgate[ob + i] = sv[i] * inv;
            }
        }
        __syncthreads();
    }
}

__device__ __forceinline__ void phase_peer_u(const Params& p) {
    PHASE_IDS
    const int lane = tid & 63, wv = bid * 4 + (tid >> 6), nwv = nblk * 4;
    const bf16_t* h2 = (const bf16_t*)(ws + OFF_H2);
    const char* U = ws + OFF_U;
    const float* US = (const float*)(ws + OFF_US);
    const float* VS = (const float*)(ws + OFF_VS);
    const int* sidx = (const int*)(ws + OFF_SIDX);
    const float* sgate = (const float*)(ws + OFF_SGATE);
    float* wbuf = (float*)(ws + OFF_PW);
    const int jl = ((lane >> 5) & 1) * 4 + ((lane >> 4) & 1) * 2 + ((lane >> 3) & 1);
    int tok = wv;
    u32x4 xa, xb;
    int id0 = 0, id1 = 0;
    float g0 = 0.f, g1 = 0.f;
    xa = xb = (u32x4){0u, 0u, 0u, 0u};
    if (tok < NTOK) {
        xa = *(const u32x4*)(h2 + (size_t)tok * 1024 + lane * 16);
        xb = *(const u32x4*)(h2 + (size_t)tok * 1024 + lane * 16 + 8);
        id0 = sidx[(size_t)tok * 128 + lane]; id1 = sidx[(size_t)tok * 128 + 64 + lane];
        g0 = sgate[(size_t)tok * 128 + lane]; g1 = sgate[(size_t)tok * 128 + 64 + lane];
    }
    for (; tok < NTOK; tok += nwv) {
        fv2_t xp[8];
#pragma unroll
        for (int i = 0; i < 4; ++i) {
            xp[i] = (fv2_t){bflo(xa[i]), bfhi(xa[i])};
            xp[4 + i] = (fv2_t){bflo(xb[i]), bfhi(xb[i])};
        }
        const float us0 = US[id0], us1 = US[id1];
        const float gv0 = g0 * VS[id0], gv1 = g1 * VS[id1];
        const int cid0 = id0, cid1 = id1;
        const int tn = tok + nwv;
        if (tn < NTOK) {
            xa = *(const u32x4*)(h2 + (size_t)tn * 1024 + lane * 16);
            xb = *(const u32x4*)(h2 + (size_t)tn * 1024 + lane * 16 + 8);
            id0 = sidx[(size_t)tn * 128 + lane]; id1 = sidx[(size_t)tn * 128 + 64 + lane];
            g0 = sgate[(size_t)tn * 128 + lane]; g1 = sgate[(size_t)tn * 128 + 64 + lane];
        }
        float wout0 = 0.f, wout1 = 0.f;
#pragma unroll 1
        for (int e0 = 0; e0 < 128; e0 += 16) {
            const int idsel = e0 < 64 ? cid0 : cid1;
            const float ussel = e0 < 64 ? us0 : us1, gvsel = e0 < 64 ? gv0 : gv1;
            const int eb = e0 & 63;
            u32x4 ur[16];
#pragma unroll
            for (int j = 0; j < 16; ++j) {
                const int eid = __builtin_amdgcn_readlane(idsel, eb + j);
                ur[j] = *(const u32x4*)(U + (size_t)eid * 1024 + lane * 16);
            }
#pragma unroll
            for (int hb = 0; hb < 2; ++hb) {
                float d[8];
#pragma unroll
                for (int j = 0; j < 8; ++j) {
                    fv2_t a2 = {0.f, 0.f};
#pragma unroll
                    for (int i = 0; i < 4; ++i) {
                        const fv2_t lo = __builtin_amdgcn_cvt_pk_f32_fp8((int)ur[hb * 8 + j][i], false);
                        const fv2_t hi = __builtin_amdgcn_cvt_pk_f32_fp8((int)ur[hb * 8 + j][i], true);
                        a2 = __builtin_elementwise_fma(lo, xp[2 * i], a2);
                        a2 = __builtin_elementwise_fma(hi, xp[2 * i + 1], a2);
                    }
                    d[j] = a2.x + a2.y;
                }
                float t4[4], t2[2], t1;
                {
                    const bool up = (lane & 32) != 0;
#pragma unroll
                    for (int i = 0; i < 4; ++i) {
                        const float keep = up ? d[4 + i] : d[i], send = up ? d[i] : d[4 + i];
                        t4[i] = keep + __shfl_xor(send, 32, 64);
                    }
                }
                {
                    const bool up = (lane & 16) != 0;
#pragma unroll
                    for (int i = 0; i < 2; ++i) {
                        const float keep = up ? t4[2 + i] : t4[i], send = up ? t4[i] : t4[2 + i];
                        t2[i] = keep + __shfl_xor(send, 16, 64);
                    }
                }
                {
                    const bool up = (lane & 8) != 0;
                    const float keep = up ? t2[1] : t2[0], send = up ? t2[0] : t2[1];
                    t1 = keep + __shfl_xor(send, 8, 64);
                }
                t1 += __shfl_xor(t1, 4, 64);
                t1 += __shfl_xor(t1, 2, 64);
                t1 += __shfl_xor(t1, 1, 64);
                const float uscl = __shfl(ussel, eb + hb * 8 + jl, 64), gvl = __shfl(gvsel, eb + hb * 8 + jl, 64);
                const float z = t1 * uscl;
                const float wl = gvl * 0.5f * z * (1.f + erff(z * 0.70710678118654752f));
                const int jj = (lane - eb - hb * 8) & 7;
                const int srcl = ((jj >> 2) & 1) * 32 + ((jj >> 1) & 1) * 16 + (jj & 1) * 8;
                const float wv_ = __shfl(wl, srcl, 64);
                const bool mine = (lane >= eb + hb * 8) && (lane < eb + hb * 8 + 8);
                if (e0 < 64) wout0 = mine ? wv_ : wout0;
                else wout1 = mine ? wv_ : wout1;
            }
        }
        wbuf[(size_t)tok * 128 + lane] = wout0;
        wbuf[(size_t)tok * 128 + 64 + lane] = wout1;
    }
}

__device__ __forceinline__ void phase_peer_v(const Params& p, char* smem) {
    PHASE_IDS_G
    const int lane = tid & 63, w = tid >> 6;
    unsigned* xcnt = (unsigned*)(ws + OFF_BAR) + 3584;
    const unsigned myx = ((volatile unsigned*)(smem + 2 * HALF_SMEM))[2], myrank = ((volatile unsigned*)(smem + 2 * HALF_SMEM))[3];
    unsigned nx = 0, myidx = 0, nloc = 1;
    for (unsigned j = 0; j < 16; ++j) {
        const unsigned c = __hip_atomic_load(xcnt + j, __ATOMIC_RELAXED, __HIP_MEMORY_SCOPE_AGENT);
        if (c > 0) {
            if (j == myx) { myidx = nx; nloc = c; }
            ++nx;
        }
    }
    const char* V = ws + OFF_V;
    const int* sidx = (const int*)(ws + OFF_SIDX);
    const float* W = (const float*)(ws + OFF_PW);
    bf16_t* pbuf = (bf16_t*)(ws + OFF_Q);
    const int colo = (lane & 7) * 16 + ((lane >> 5) & 1) * 8 + ((lane >> 4) & 1) * 4 + ((lane >> 3) & 1) * 2;
    for (unsigned part = myidx; part < 8; part += nx) {
        const int tstep = (int)(nloc * 8);
        int tok = (int)(myrank * 8 + w);
        int id0 = 0, id1 = 0;
        float w0 = 0.f, w1 = 0.f;
        if (tok < NTOK) {
            id0 = sidx[(size_t)tok * 128 + lane]; id1 = sidx[(size_t)tok * 128 + 64 + lane];
            w0 = W[(size_t)tok * 128 + lane]; w1 = W[(size_t)tok * 128 + 64 + lane];
        }
        for (; tok < NTOK; tok += tstep) {
            const int tn = tok + tstep;
            int nid0 = 0, nid1 = 0;
            float nw0 = 0.f, nw1 = 0.f;
            if (tn < NTOK) {
                nid0 = sidx[(size_t)tn * 128 + lane]; nid1 = sidx[(size_t)tn * 128 + 64 + lane];
                nw0 = W[(size_t)tn * 128 + lane]; nw1 = W[(size_t)tn * 128 + 64 + lane];
            }
            fv2_t acc2[8];
#pragma unroll
            for (int i = 0; i < 8; ++i) acc2[i] = (fv2_t){0.f, 0.f};
#pragma unroll 1
            for (int hb = 0; hb < 2; ++hb) {
                const int idsel = hb ? id1 : id0;
                const float wsel = hb ? w1 : w0;
                u32x4 vv[8];
                float wg[8];
#pragma unroll
                for (int bt = 0; bt < 8; ++bt) {
                    const int slot = bt * 8 + (lane >> 3);
                    const int eid = __shfl(idsel, slot, 64);
                    wg[bt] = __shfl(wsel, slot, 64);
                    vv[bt] = *(const u32x4*)(V + (size_t)part * (16384 * 128) + (size_t)eid * 128 + (lane & 7) * 16);
                }
#pragma unroll
                for (int bt = 0; bt < 8; ++bt) {
#pragma unroll
                    for (int i = 0; i < 4; ++i) {
                        const fv2_t lo = __builtin_amdgcn_cvt_pk_f32_fp8((int)vv[bt][i], false);
                        const fv2_t hi = __builtin_amdgcn_cvt_pk_f32_fp8((int)vv[bt][i], true);
                        const fv2_t w2 = {wg[bt], wg[bt]};
                        acc2[2 * i] = __builtin_elementwise_fma(w2, lo, acc2[2 * i]);
                        acc2[2 * i + 1] = __builtin_elementwise_fma(w2, hi, acc2[2 * i + 1]);
                    }
                }
            }
            float acc[16];
#pragma unroll
            for (int i = 0; i < 8; ++i) { acc[2 * i] = acc2[i].x; acc[2 * i + 1] = acc2[i].y; }
            float t8[8], t4[4], t2[2];
            {
                const bool up = (lane & 32) != 0;
#pragma unroll
                for (int i = 0; i < 8; ++i) {
                    const float keep = up ? acc[8 + i] : acc[i], send = up ? acc[i] : acc[8 + i];
                    t8[i] = keep + __shfl_xor(send, 32, 64);
                }
            }
            {
                const bool up = (lane & 16) != 0;
#pragma unroll
                for (int i = 0; i < 4; ++i) {
                    const float keep = up ? t8[4 + i] : t8[i], send = up ? t8[i] : t8[4 + i];
                    t4[i] = keep + __shfl_xor(send, 16, 64);
                }
            }
            {
                const bool up = (lane & 8) != 0;
#pragma unroll
                for (int i = 0; i < 2; ++i) {
                    const float keep = up ? t4[2 + i] : t4[i], send = up ? t4[i] : t4[2 + i];
                    t2[i] = keep + __shfl_xor(send, 8, 64);
                }
            }
            *(unsigned*)(pbuf + (size_t)tok * 1024 + (int)part * 128 + colo) = pk2(t2[0], t2[1]);
            id0 = nid0; id1 = nid1; w0 = nw0; w1 = nw1;
        }
    }
}

__device__ __forceinline__ void phase_final(const Params& p) {
    PHASE_IDS
    const int lane = tid & 63, wv = bid * 4 + (tid >> 6), nwv = nblk * 4;
    const bf16_t* pbuf = (const bf16_t*)(ws + OFF_Q);
    const float* mod = (const float*)(ws + OFF_MOD);
    float4 fg[4];
#pragma unroll
    for (int hq = 0; hq < 4; ++hq) fg[hq] = *(const float4*)(p.final_g + (hq >> 1) * 512 + lane * 8 + (hq & 1) * 4);
    constexpr int R = 2;
    for (int tok = wv * R; tok < NTOK; tok += nwv * R) {
        const float* g2 = mod + (size_t)(tok >> 11) * NMOD + 5120;
        float4 xv[R][4];
        u32x4 pv[R][2];
#pragma unroll
        for (int r = 0; r < R; ++r) {
            const float* orow = p.out + (size_t)(tok + r) * 1024;
#pragma unroll
            for (int hq = 0; hq < 4; ++hq) xv[r][hq] = *(const float4*)(orow + (hq >> 1) * 512 + lane * 8 + (hq & 1) * 4);
            pv[r][0] = *(const u32x4*)(pbuf + (size_t)(tok + r) * 1024 + lane * 8);
            pv[r][1] = *(const u32x4*)(pbuf + (size_t)(tok + r) * 1024 + 512 + lane * 8);
        }
        float4 gv[4];
#pragma unroll
        for (int hq = 0; hq < 4; ++hq) gv[hq] = *(const float4*)(g2 + (hq >> 1) * 512 + lane * 8 + (hq & 1) * 4);
#pragma unroll
        for (int r = 0; r < R; ++r) {
            float4 x2[4];
            float ss = 0.f;
#pragma unroll
            for (int hq = 0; hq < 4; ++hq) {
                const unsigned u0 = pv[r][hq >> 1][(hq & 1) * 2], u1 = pv[r][hq >> 1][(hq & 1) * 2 + 1];
                x2[hq].x = xv[r][hq].x + gv[hq].x * bflo(u0);
                x2[hq].y = xv[r][hq].y + gv[hq].y * bfhi(u0);
                x2[hq].z = xv[r][hq].z + gv[hq].z * bflo(u1);
                x2[hq].w = xv[r][hq].w + gv[hq].w * bfhi(u1);
                ss += x2[hq].x * x2[hq].x + x2[hq].y * x2[hq].y + x2[hq].z * x2[hq].z + x2[hq].w * x2[hq].w;
            }
            ss = wave_sum(ss);
            const float rs = rsqrtf(ss * (1.f / 1024.f) + EPS);
            float* orow = p.out + (size_t)(tok + r) * 1024;
#pragma unroll
            for (int hq = 0; hq < 4; ++hq) {
                float4 o;
                o.x = x2[hq].x * rs * fg[hq].x; o.y = x2[hq].y * rs * fg[hq].y; o.z = x2[hq].z * rs * fg[hq].z; o.w = x2[hq].w * rs * fg[hq].w;
                *(float4*)(orow + (hq >> 1) * 512 + lane * 8 + (hq & 1) * 4) = o;
            }
        }
    }
}

#ifndef DBG
#define DBG 0
#ifndef DUP
#define DUP 0
#endif
#endif
__device__ __forceinline__ void phase_dump(const Params& p) {
    PHASE_IDS
    for (size_t i = (size_t)bid * 256 + tid; i < (size_t)NTOK * 1024; i += (size_t)nblk * 256) {
        float v = 0.f;
        if (DBG == 1) {
            if (i < 33 * NMOD) v = ((const float*)(ws + OFF_MOD))[i];
            else v = bf2f(((const bf16_t*)ws)[i]);
        } else if (DBG == 2) {
            const size_t row = (i >> 12) % GLAT, col = (i & 4095) * 3;
            v = bf2f(((const bf16_t*)(ws + OFF_PROJ))[row * PW + col]);
        } else if (DBG == 6) {
            if (i < (size_t)GLAT * 1024) { const size_t row = i >> 10, col = C_GLF + (i & 1023); v = bf2f(((const bf16_t*)(ws + OFF_PROJ))[row * PW + col]); }
            else if (i < (size_t)GLAT * 1024 + (size_t)GCTX * 4096) { const size_t j = i - (size_t)GLAT * 1024; const size_t row = GLAT + (j >> 12); const int cc = (int)(j & 4095);
                const int col = cc < 3072 ? 1024 + cc + (cc >= 2048 ? 1024 : 0) + 0 : (cc < 3584 ? C_GK + (cc - 3072) : C_GLF + (cc - 3584) * 2);
                v = bf2f(((const bf16_t*)(ws + OFF_PROJ))[row * PW + col]); }
        } else if (DBG == 3) {
            v = bf2f(((const bf16_t*)(ws + OFF_O))[i]);
        } else if (DBG == 4) {
            v = (i < (size_t)GLAT * 1024) ? p.out[i] : 0.f;
        } else if (DBG == 5) {
            v = (i < (size_t)NTOK * 128) ? (float)((const int*)(ws + OFF_SIDX))[i] : ((i < (size_t)NTOK * 256) ? ((const float*)(ws + OFF_SGATE))[i - (size_t)NTOK * 128] : 0.f);
        }
        if (!(fabsf(v) < 1e30f)) v = 12345.f;
        p.out[i] = v;
    }
}
constexpr int N_PHASES = 3 + NG * 5 + 6;

__global__ void __launch_bounds__(512, 2) mega(Params p) {
    extern __shared__ __attribute__((aligned(16))) char smem[];
    cg::grid_group grid = cg::this_grid();
    if (threadIdx.x < 4) ((unsigned*)(smem + 2 * HALF_SMEM))[threadIdx.x] = 0u;
    __syncthreads();
    const XcdBarrier xb = xcd_barrier_post((unsigned*)(p.ws + OFF_BAR), (volatile LAS unsigned*)(smem + 2 * HALF_SMEM));
    if (threadIdx.x == 0) {
        volatile unsigned* stw = (volatile unsigned*)(smem + 2 * HALF_SMEM);
        stw[2] = xb.x;
        stw[3] = __hip_atomic_fetch_add((unsigned*)(p.ws + OFF_BAR) + 3584 + xb.x, 1u, __ATOMIC_RELAXED, __HIP_MEMORY_SCOPE_AGENT);
    }
    if (p.phase_hi < 0) grid.sync();
    for (int ph = p.phase_lo; ph < p.phase_hi; ++ph) {
        if (ph == 99) phase_dump(p);
        else if (ph == 0) { phase_prep(p, smem); if (DUP == 8) { __syncthreads(); phase_prep(p, smem); } }
        else if (ph == 1) phase_modreduce(p);
        else if (ph == 2) phase_hprep(p, 0);
        else if (ph < 3 + NG * 5) {
            const int g = (ph - 3) / 5, s = (ph - 3) % 5;
            if (s == 0) phase_gemm_in(p, smem);
            else if (s == 1) phase_scan2(p, smem);
            else if (s == 2) {
                phase_headnorm(p);
                if (g + 1 < NG) phase_hprep(p, g + 1);
            } else if (s == 3) phase_branch(p, smem);
            else phase_outproj(p, g, smem);
        } else {
            const int s = ph - (3 + NG * 5);
            if (s == 0) phase_h2(p);
            else if (s == 1) phase_qproj(p, smem);
            else if (s == 2) phase_topk(p, smem);
            else if (s == 3) phase_peer_u(p);
            else if (s == 4) phase_peer_v(p, smem);
            else phase_final(p);
        }
        if (ph + 1 < p.phase_hi) {
            xcd_barrier(xb);
        }
    }
}

extern "C" void kernel_launch(void* const* d_in, const int* in_sizes, int n_in, void* d_out, int out_size, void* d_ws, size_t ws_size,
                              hipStream_t stream) {
    static int grid_blocks = 0;
    if (!grid_blocks) {
        int dev = 0, cus = 0, per_cu = 0;
        hipGetDevice(&dev);
        hipDeviceGetAttribute(&cus, hipDeviceAttributeMultiprocessorCount, dev);
        hipFuncSetAttribute((const void*)mega, hipFuncAttributeMaxDynamicSharedMemorySize, SMEM_BYTES);
        hipOccupancyMaxActiveBlocksPerMultiprocessor(&per_cu, mega, 512, SMEM_BYTES);
        if (per_cu > 1) per_cu = 1;
        if (per_cu < 1) per_cu = 1;
        grid_blocks = cus * per_cu;
    }
    Params p{};
    const float** f = (const float**)&p;
    for (int i = 0; i < 23; ++i) f[i] = (const float*)d_in[i];
    p.out = (float*)d_out;
    p.ws = (char*)d_ws;
    if (ws_size < WS_END) { fprintf(stderr, "workspace too small\n"); return; }
#ifdef MULTI_LAUNCH
    const int dbgK[7] = {N_PHASES, 2, 4, 5, 8, N_PHASES - 1, 4};
    for (int ph = 0; ph < dbgK[DBG]; ++ph) {
        p.phase_lo = ph;
        p.phase_hi = ph + 1;
        hipLaunchKernelGGL(mega, dim3(grid_blocks), dim3(512), SMEM_BYTES, stream, p);
    }
    if (DBG) {
        p.phase_lo = 99;
        p.phase_hi = 100;
        hipLaunchKernelGGL(mega, dim3(grid_blocks), dim3(512), SMEM_BYTES, stream, p);
    }
#else
    p.phase_lo = 0;
    p.phase_hi = N_PHASES;
    hipMemsetAsync((char*)d_ws + OFF_BAR, 0, 16384, stream);
    void* args[] = {&p};
    hipError_t e = hipLaunchCooperativeKernel((const void*)mega, dim3(grid_blocks), dim3(512), args, SMEM_BYTES, stream);
    if (e != hipSuccess) fprintf(stderr, "cooperative launch failed: %s (grid %d)\n", hipGetErrorString(e), grid_blocks);
#endif
}
```

```cpp
#include <hip/hip_runtime.h>
#include <hip/hip_cooperative_groups.h>
#include <cstdio>

#define DBG 0
#ifndef DUP
#define DUP 0
#endif
namespace cg = cooperative_groups;

typedef unsigned short bf16_t;
typedef short bf16x8 __attribute__((ext_vector_type(8)));
typedef float f32x16 __attribute__((ext_vector_type(16)));
typedef __bf16 bfv2 __attribute__((ext_vector_type(2)));

constexpr int D = 1024, BATCH = 32, SEQ = 2048, CTXL = 256;
constexpr int NTOK = BATCH * SEQ;
constexpr int NG = 4, GB = 8;
constexpr int GLAT = GB * SEQ;
constexpr int GCTX = GB * CTXL;
constexpr int GROWS = GLAT + GCTX;
constexpr int NW = 11264;
constexpr int PW = 13312;
constexpr int DIN = 10272;
constexpr int NMOD = 6144;
constexpr int KSPL = 8;
constexpr float EPS = 1e-6f;
constexpr int C_HQ = 0, C_HKF = 1024, C_HLF = 2048, C_HKB = 3072, C_HLB = 4096, C_HV = 5120, C_HSG = 6144,
              C_GQ = 7168, C_GK = 7680, C_GV = 8192, C_GSG = 9216, C_MH = 10240, C_MG = 11264, C_GLF = 12288, C_GLB = 12800;

constexpr size_t MiB = 1024 * 1024;
constexpr size_t OFF_WIN = 0;
constexpr size_t OFF_WBRH = OFF_WIN + (size_t)NW * 1024 * 2;
constexpr size_t OFF_WBRG = OFF_WBRH + 2 * MiB;
constexpr size_t OFF_WO = OFF_WBRG + 2 * MiB;
constexpr size_t OFF_WQ = OFF_WO + 2 * MiB;
constexpr size_t OFF_K1 = OFF_WQ + 4 * MiB;
constexpr size_t OFF_K2 = OFF_K1 + 32768;
constexpr size_t OFF_U = OFF_K2 + 32768;
constexpr size_t OFF_V = OFF_U + 32 * MiB;
constexpr size_t OFF_MODP = OFF_V + 32 * MiB;
constexpr size_t OFF_MOD = OFF_MODP + (size_t)KSPL * 33 * NMOD * 4;
constexpr size_t OFF_LB = OFF_MOD + (size_t)33 * NMOD * 4;
constexpr size_t OFF_BAR = OFF_LB + 8192;
constexpr size_t OFF_US = OFF_BAR + 16384;
constexpr size_t OFF_VS = OFF_US + 65536;
constexpr size_t OFF_SS = OFF_VS + 65536;
constexpr size_t OFF_H = OFF_SS + 262144;
constexpr size_t OFF_PROJ = OFF_H + (size_t)GROWS * 1024 * 2;
constexpr size_t OFF_O = OFF_PROJ + (size_t)GROWS * PW * 2;
constexpr size_t OFF_YN = OFF_O + (size_t)4 * GLAT * 1024 * 2;
constexpr size_t OFF_Y1 = OFF_YN + (size_t)2 * GLAT * 1024 * 2;
constexpr size_t OFF_Y = OFF_Y1 + (size_t)GLAT * 1024 * 4;
constexpr size_t WS_END = OFF_Y + (size_t)GLAT * 1024 * 2;
constexpr size_t OFF_H2 = OFF_PROJ;
constexpr size_t OFF_Q = OFF_H2 + (size_t)NTOK * 1024 * 2;
constexpr size_t OFF_SIDX = OFF_Q + (size_t)NTOK * 2048 * 2;
constexpr size_t OFF_SGATE = OFF_SIDX + (size_t)NTOK * 128 * 4;
constexpr size_t OFF_PW = OFF_O;
constexpr size_t OFF_PW_UNUSED = OFF_Q + (size_t)NTOK * 1024 * 2;
static_assert(OFF_SGATE + (size_t)NTOK * 128 * 4 <= OFF_O, "peer alias overflow");
static_assert(WS_END <= 1024 * MiB, "workspace too large");

constexpr int HALF_SMEM = 79360;
constexpr int SMEM_BYTES = 2 * HALF_SMEM + 16;

struct Params {
    const float *x, *c, *ctx, *c_ctx, *ada_w, *ada_b, *norm_mix_g, *w_in, *lb_logits, *hg_norm_g, *gk_w, *gk_b, *gla_norm_g,
        *w_br_hg, *w_br_gla, *w_out, *norm_ffn_g, *wq, *k1, *k2, *u, *v, *final_g;
    float* out;
    char* ws;
    int phase_lo, phase_hi;
};

typedef unsigned u32x4 __attribute__((ext_vector_type(4)));
#define OPQV(x) asm volatile("" : "+v"(x))
#define OPQS(x) asm volatile("" : "+s"(x))
#define PHASE_IDS                                                         \
    int traw_ = threadIdx.x;                                              \
    OPQV(traw_);                                                          \
    int tid = traw_ & 255;                                                \
    const int half_ = __builtin_amdgcn_readfirstlane(traw_ >> 8);         \
    int bid = blockIdx.x * 2 + half_;                                     \
    OPQS(bid);                                                            \
    int nblk = gridDim.x * 2;                                             \
    OPQS(nblk);                                                           \
    unsigned long long wz_ = 0ull;                                        \
    OPQS(wz_);                                                            \
    char* ws = p.ws + wz_;
#define PHASE_IDS_G                     \
    int tid = threadIdx.x;              \
    OPQV(tid);                          \
    int bid = blockIdx.x;               \
    OPQS(bid);                          \
    int nblk = gridDim.x;               \
    OPQS(nblk);                         \
    unsigned long long wz_ = 0ull;      \
    OPQS(wz_);                          \
    char* ws = p.ws + wz_;
__device__ __forceinline__ float bf2f(bf16_t b) { return __uint_as_float(((unsigned)b) << 16); }
typedef float fv2_t __attribute__((ext_vector_type(2)));
__device__ __forceinline__ unsigned pk2(float lo, float hi) {
    const fv2_t f = {lo, hi};
    const bfv2 b = __builtin_convertvector(f, bfv2);
    return __builtin_bit_cast(unsigned, b);
}
__device__ __forceinline__ bf16_t f2bf(float f) { return (bf16_t)(pk2(f, 0.f) & 0xffffu); }
__device__ __forceinline__ float bflo(unsigned u) { return __uint_as_float(u << 16); }
__device__ __forceinline__ float bfhi(unsigned u) { return __uint_as_float(u & 0xffff0000u); }
__device__ __forceinline__ float sigmoidf_(float x) { return __builtin_amdgcn_rcpf(1.f + __expf(-x)); }
__device__ __forceinline__ float wave_sum(float v) {
#pragma unroll
    for (int o = 32; o > 0; o >>= 1) v += __shfl_xor(v, o, 64);
    return v;
}

#define XB_TMO      128
#define XB_XCNT(j)  (256  + 64 * (j))
#define XB_XSUB(j)  (1280 + 64 * (j))
#define XB_XGEN(j)  (2304 + 64 * (j))
#define XB_TOP      3328
#define XB_TOPGEN   3392
#define XCD_BAR_WORDS 3456
#define XB_SPIN_CAP (1u << 18)
#define LAS __attribute__((address_space(3)))

__device__ __forceinline__ unsigned xb_ld(unsigned* p)              { return __hip_atomic_load(p, __ATOMIC_RELAXED, __HIP_MEMORY_SCOPE_AGENT); }
__device__ __forceinline__ unsigned xb_add(unsigned* p, unsigned v) { return __hip_atomic_fetch_add(p, v, __ATOMIC_RELAXED, __HIP_MEMORY_SCOPE_AGENT); }
__device__ __forceinline__ unsigned xb_xcc_id() { return (unsigned)__builtin_amdgcn_s_getreg((3 << 11) | 20) & 0xFu; }
#define XB_SPIN(cond, bar) do { unsigned _sp = 0; while (cond) { __builtin_amdgcn_s_sleep(1); \
    if ((++_sp & 255u) == 0u) { if (xb_ld(&(bar)[XB_TMO])) break; if (_sp > XB_SPIN_CAP) { atomicAdd(&(bar)[XB_TMO], 1u); break; } } } } while (0)

struct XcdBarrier {
    unsigned* bar; unsigned x;
    volatile LAS unsigned* st;
};

__device__ __forceinline__ XcdBarrier xcd_barrier_post(unsigned* bar, volatile LAS unsigned* st) {
    XcdBarrier b; b.bar = bar; b.x = xb_xcc_id(); b.st = st;
    if (threadIdx.x == 0) (void)xb_add(&bar[XB_XCNT(b.x)], 1u);
    return b;
}
__device__ __forceinline__ void xcd_barrier_complete(unsigned* bar, unsigned x, unsigned& nloc, unsigned& nx) {
    const unsigned G = gridDim.x * gridDim.y * gridDim.z;
    unsigned sum, cnt, mine, sp = 0u;
    for (;;) {
        sum = 0u; cnt = 0u; mine = 0u;
#pragma unroll
        for (unsigned j = 0; j < 16; ++j) { const unsigned c = xb_ld(&bar[XB_XCNT(j)]); sum += c; cnt += (c > 0u) ? 1u : 0u; mine = (j == x) ? c : mine; }
        if (sum == G) break;
        __builtin_amdgcn_s_sleep(1);
        if ((++sp & 255u) == 0u) { if (xb_ld(&bar[XB_TMO])) break; if (sp > XB_SPIN_CAP) { atomicAdd(&bar[XB_TMO], 1u); break; } }
    }
    nloc = mine > 0u ? mine : 1u; nx = cnt > 0u ? cnt : 1u;
}

__device__ __forceinline__ void xcd_barrier(const XcdBarrier& b) {
    asm volatile("s_waitcnt vmcnt(0)" ::: "memory");
    __syncthreads();
    if (threadIdx.x == 0) {
        unsigned* bar = b.bar;
        __builtin_amdgcn_s_waitcnt(0);
        unsigned nloc = b.st[0], nx = b.st[1];
        if (nloc == 0u) { xcd_barrier_complete(bar, b.x, nloc, nx); b.st[0] = nloc; b.st[1] = nx; }
        const unsigned old = xb_add(&bar[XB_XSUB(b.x)], 1u);
        const unsigned gen = old / nloc;
        if (old + 1u == (gen + 1u) * nloc) {
            __builtin_amdgcn_fence(__ATOMIC_RELEASE, "agent");
            asm volatile("s_waitcnt vmcnt(0)" ::: "memory");
            const unsigned og = xb_add(&bar[XB_TOP], 1u);
            const unsigned tg = og / nx;
            if (og + 1u == (tg + 1u) * nx) xb_add(&bar[XB_TOPGEN], 1u);
            else XB_SPIN(xb_ld(&bar[XB_TOPGEN]) == tg, bar);
            __builtin_amdgcn_fence(__ATOMIC_ACQUIRE, "agent");
            xb_add(&bar[XB_XGEN(b.x)], 1u);
            asm volatile("s_waitcnt vmcnt(0)" ::: "memory");
        } else {
            XB_SPIN(xb_ld(&bar[XB_XGEN(b.x)]) == gen, bar);
            __builtin_amdgcn_fence(__ATOMIC_ACQUIRE, "agent");
            asm volatile("s_waitcnt vmcnt(0)" ::: "memory");
        }
    }
    __syncthreads();
}

__device__ __forceinline__ int swz64(int row, int c) { return row * 128 + ((c ^ ((row >> 1) & 7)) << 4); }

template <class F, class G>
__device__ __forceinline__ void staged_store(const f32x16 (&acc)[2][4], char* st, int lane, const F& f, const G& g) {
    const int l31 = lane & 31, hh = lane >> 5;
#pragma unroll
    for (int mh = 0; mh < 2; ++mh) {
#pragma unroll
        for (int ni = 0; ni < 2; ++ni)
#pragma unroll
            for (int m2 = 0; m2 < 2; ++m2)
#pragma unroll
                for (int gq = 0; gq < 4; ++gq) {
                    const int mi = mh * 2 + m2;
                    float o0, o1, o2, o3;
                    f(ni * 32 + 8 * gq + 4 * hh, acc[ni][mi][4 * gq + 0], acc[ni][mi][4 * gq + 1], acc[ni][mi][4 * gq + 2], acc[ni][mi][4 * gq + 3], o0, o1, o2, o3);
                    uint2 v;
                    v.x = pk2(o0, o1);
                    v.y = pk2(o2, o3);
                    *(uint2*)(st + (m2 * 32 + l31) * 144 + (ni * 32 + 8 * gq + 4 * hh) * 2) = v;
                    __builtin_amdgcn_sched_barrier(0);
                }
#pragma unroll 4
        for (int j = 0; j < 8; ++j) {
            const int r = j * 8 + (lane >> 3);
            const u32x4 v = *(const u32x4*)(st + r * 144 + (lane & 7) * 16);
            g(mh * 64 + r, (lane & 7) * 8, v);
        }
    }
}

template <class Epi>
__device__ __forceinline__ void gemm_tile(const bf16_t* __restrict__ A, int lda, const bf16_t* __restrict__ Bt, int K, int pm, int pn,
                                          const Epi& epi, char* smem, const int tid, const bool preloaded, const char* nAbase, const char* nBbase) {
    const int lane = tid & 63, wid = tid >> 6, wm = wid & 1, wn = wid >> 1;
    const int l31 = lane & 31, hh = lane >> 5;
    f32x16 acc[2][4];
#pragma unroll
    for (int a = 0; a < 2; ++a)
#pragma unroll
        for (int b = 0; b < 4; ++b)
#pragma unroll
            for (int i = 0; i < 16; ++i) acc[a][b][i] = 0.f;
    const int row0 = tid >> 3, c0 = (tid & 7) ^ ((tid >> 4) & 7);
    const unsigned offA = (unsigned)(row0 * lda + c0 * 8) * 2u, offB = (unsigned)(row0 * K + c0 * 8) * 2u;
    const char* Abase = (const char*)(A + (size_t)(pm * 256) * lda);
    const char* Bbase = (const char*)(Bt + (size_t)(pn * 256) * K);
#define DMA_TILE(stage, k0)                                                                                                   \
    {                                                                                                                         \
        _Pragma("unroll") for (int i = 0; i < 4; ++i)                                                                         \
            __builtin_amdgcn_global_load_lds((const unsigned*)(Abase + (size_t)((i * 64) * lda + (k0)) * 2 + offA), (LAS unsigned*)(smem + (stage) * 65536 + (i * 512 + tid) * 16), 16, 0, 0);        \
        _Pragma("unroll") for (int i = 0; i < 4; ++i)                                                                         \
            __builtin_amdgcn_global_load_lds((const unsigned*)(Bbase + (size_t)((i * 64) * K + (k0)) * 2 + offB), (LAS unsigned*)(smem + (stage) * 65536 + 32768 + (i * 512 + tid) * 16), 16, 0, 0); \
    }
    if (!preloaded) { DMA_TILE(0, 0); }
    asm volatile("s_waitcnt vmcnt(0)" ::: "memory");
    __syncthreads();
    const int nk = K >> 6;
#define DMA_PIECE(stage, k0, q)                                                                                               \
    {                                                                                                                         \
        if ((q) < 4)                                                                                                          \
            __builtin_amdgcn_global_load_lds((const unsigned*)(Abase + (size_t)(((q) * 64) * lda + (k0)) * 2 + offA), (LAS unsigned*)(smem + (stage) * 65536 + ((q) * 512 + tid) * 16), 16, 0, 0); \
        else                                                                                                                  \
            __builtin_amdgcn_global_load_lds((const unsigned*)(Bbase + (size_t)((((q) - 4) * 64) * K + (k0)) * 2 + offB), (LAS unsigned*)(smem + (stage) * 65536 + 32768 + (((q) - 4) * 512 + tid) * 16), 16, 0, 0); \
    }
#pragma unroll 1
    for (int kt = 0; kt < nk; ++kt) {
        const bool more = kt + 1 < nk;
        const int nst = (kt + 1) & 1, nk0 = (kt + 1) * 64;
        const char* sa = smem + (kt & 1) * 65536;
        const char* sb = sa + 32768;
#pragma unroll
        for (int kk = 0; kk < 4; ++kk) {
            bf16x8 fa[2], fb[4];
#pragma unroll
            for (int ni = 0; ni < 2; ++ni) fa[ni] = *(const bf16x8*)(sb + swz64(wn * 64 + ni * 32 + l31, kk * 2 + hh));
#pragma unroll
            for (int mi = 0; mi < 4; ++mi) fb[mi] = *(const bf16x8*)(sa + swz64(wm * 128 + mi * 32 + l31, kk * 2 + hh));
            __builtin_amdgcn_s_setprio(1);
#pragma unroll
            for (int ni = 0; ni < 2; ++ni)
#pragma unroll
                for (int mi = 0; mi < 4; ++mi) acc[ni][mi] = __builtin_amdgcn_mfma_f32_32x32x16_bf16(fa[ni], fb[mi], acc[ni][mi], 0, 0, 0);
            __builtin_amdgcn_s_setprio(0);
            __builtin_amdgcn_sched_barrier(0);
            if (more) {
                if (kk == 0) { DMA_PIECE(nst, nk0, 0); DMA_PIECE(nst, nk0, 1); DMA_PIECE(nst, nk0, 2); }
                if (kk == 1) { DMA_PIECE(nst, nk0, 3); DMA_PIECE(nst, nk0, 4); DMA_PIECE(nst, nk0, 5); }
                if (kk == 2) { DMA_PIECE(nst, nk0, 6); DMA_PIECE(nst, nk0, 7); }
            }
            __builtin_amdgcn_sched_barrier(0);
        }
        asm volatile("s_waitcnt vmcnt(0)" ::: "memory");
        __syncthreads();
    }
#undef DMA_PIECE
#undef DMA_TILE
    if (nAbase) {
#pragma unroll
        for (int i = 0; i < 4; ++i)
            __builtin_amdgcn_global_load_lds((const unsigned*)(nAbase + (size_t)((i * 64) * lda) * 2 + offA), (LAS unsigned*)(smem + (i * 512 + tid) * 16), 16, 0, 0);
#pragma unroll
        for (int i = 0; i < 4; ++i)
            __builtin_amdgcn_global_load_lds((const unsigned*)(nBbase + (size_t)((i * 64) * K) * 2 + offB), (LAS unsigned*)(smem + 32768 + (i * 512 + tid) * 16), 16, 0, 0);
    }
    if constexpr (Epi::STAGED) {
        epi.run(acc, smem + 65536 + wid * 9216, lane, pm * 256 + wm * 128, pn * 256 + wn * 64);
    } else {
#pragma unroll
        for (int ni = 0; ni < 2; ++ni)
#pragma unroll
            for (int mi = 0; mi < 4; ++mi)
#pragma unroll
                for (int g = 0; g < 4; ++g) {
                    const int m = pm * 256 + wm * 128 + mi * 32 + l31;
                    const int n0 = pn * 256 + wn * 64 + ni * 32 + 8 * g + 4 * hh;
                    epi(m, n0, acc[ni][mi][4 * g + 0], acc[ni][mi][4 * g + 1], acc[ni][mi][4 * g + 2], acc[ni][mi][4 * g + 3]);
                }
    }
}

__device__ __forceinline__ bool tile_map(int v, int nM, int nN, int& pm, int& pn) {
    const int SM = 8, SN = nN < 8 ? nN : 8, TS = SM * SN;
    const int xcd = v & 7, slot = v >> 3;
    const int q = slot / TS, r = slot - q * TS;
    const int nSM = (nM + SM - 1) / SM, nSN = (nN + SN - 1) / SN;
    const int Sg = q * 8 + xcd;
    if (Sg >= nSM * nSN) return false;
    const int sm = Sg / nSN, sn = Sg - sm * nSN;
    pm = sm * SM + (r % SM);
    pn = sn * SN + (r / SM);
    return pm < nM && pn < nN;
}
__device__ __forceinline__ int tile_total(int nM, int nN) {
    const int SN = nN < 8 ? nN : 8;
    const int nS = ((nM + 7) / 8) * ((nN + SN - 1) / SN);
    return ((nS + 7) / 8) * 8 * 8 * SN;
}

__device__ __forceinline__ void st_bf4(bf16_t* p, float a, float b, float c, float d) {
    uint2 v;
    v.x = pk2(a, b);
    v.y = pk2(c, d);
    *(uint2*)p = v;
}

#define SS_ARGS int c, float a0, float a1, float a2, float a3, float &o0, float &o1, float &o2, float &o3
#define SG_ARGS int r, int c8, u32x4 v
template <class F>
__device__ __forceinline__ void staged_store_dst(const f32x16 (&acc)[2][4], char* st, int lane, bf16_t* dst0, size_t ld, const F& f) {
    staged_store(acc, st, lane, f, [dst0, ld](SG_ARGS) { *(u32x4*)(dst0 + (size_t)r * ld + c8) = v; });
}
struct EpiProj {
    static constexpr bool STAGED = true;
    bf16_t* proj;
    const float* lb;
    const float* gkb;
    __device__ __forceinline__ void run(const f32x16 (&acc)[2][4], char* st, int lane, int mrow0, int nbase) const {
        bf16_t* row0 = proj + (size_t)mrow0 * PW;
        if (nbase < 1024 || (nbase >= 5120 && nbase < 5632)) {
            const int col = nbase < 1024 ? C_HQ + nbase : C_GQ + (nbase - 5120);
            staged_store_dst(acc, st, lane, row0 + col, PW, [](SS_ARGS) { const float s = 0.08838834764831845f; o0 = a0 * s; o1 = a1 * s; o2 = a2 * s; o3 = a3 * s; });
        } else if (nbase < 3072) {
            const int dir = nbase >= 2048, j = nbase - 1024 - dir * 1024;
            const float* lbp = lb + dir * 1024 + j;
            staged_store_dst(acc, st, lane, row0 + (dir ? C_HKB : C_HKF) + j, PW, [lbp](SS_ARGS) {
                const float4 l4 = *(const float4*)(lbp + c);
                o0 = (1.f - l4.x) * (1.f - sigmoidf_(a0)); o1 = (1.f - l4.y) * (1.f - sigmoidf_(a1));
                o2 = (1.f - l4.z) * (1.f - sigmoidf_(a2)); o3 = (1.f - l4.w) * (1.f - sigmoidf_(a3));
            });
            staged_store_dst(acc, st, lane, row0 + (dir ? C_HLB : C_HLF) + j, PW, [lbp](SS_ARGS) {
                asm volatile("" : "+v"(a0), "+v"(a1), "+v"(a2), "+v"(a3));
                const float4 l4 = *(const float4*)(lbp + c);
                o0 = __logf(l4.x + (1.f - l4.x) * sigmoidf_(a0)); o1 = __logf(l4.y + (1.f - l4.y) * sigmoidf_(a1));
                o2 = __logf(l4.z + (1.f - l4.z) * sigmoidf_(a2)); o3 = __logf(l4.w + (1.f - l4.w) * sigmoidf_(a3));
            });
        } else if (nbase < 4096 || (nbase >= 5632 && nbase < 7168)) {
            const int col = nbase < 4096 ? C_HV + (nbase - 3072) : (nbase < 6144 ? C_GK + (nbase - 5632) : C_GV + (nbase - 6144));
            staged_store_dst(acc, st, lane, row0 + col, PW, [](SS_ARGS) { o0 = a0; o1 = a1; o2 = a2; o3 = a3; });
        } else if (nbase < 5120 || (nbase >= 7168 && nbase < 8192)) {
            const int col = nbase < 5120 ? C_HSG + (nbase - 4096) : C_GSG + (nbase - 7168);
            staged_store_dst(acc, st, lane, row0 + col, PW,
                         [](SS_ARGS) { o0 = a0 * sigmoidf_(a0); o1 = a1 * sigmoidf_(a1); o2 = a2 * sigmoidf_(a2); o3 = a3 * sigmoidf_(a3); });
        } else if (nbase < 10240) {
            staged_store_dst(acc, st, lane, row0 + C_MH + (nbase - 8192), PW,
                         [](SS_ARGS) { o0 = sigmoidf_(a0); o1 = sigmoidf_(a1); o2 = sigmoidf_(a2); o3 = sigmoidf_(a3); });
        } else {
            const float* bp = gkb + (nbase - 10240);
            staged_store_dst(acc, st, lane, row0 + C_GLF + (nbase - 10240), PW, [bp](SS_ARGS) {
                const float4 b4 = *(const float4*)(bp + c);
                const float z0 = a0 + b4.x, z1 = a1 + b4.y, z2 = a2 + b4.z, z3 = a3 + b4.w;
                o0 = -(fmaxf(-z0, 0.f) + __logf(1.f + __expf(-fabsf(z0)))) * 0.0625f;
                o1 = -(fmaxf(-z1, 0.f) + __logf(1.f + __expf(-fabsf(z1)))) * 0.0625f;
                o2 = -(fmaxf(-z2, 0.f) + __logf(1.f + __expf(-fabsf(z2)))) * 0.0625f;
                o3 = -(fmaxf(-z3, 0.f) + __logf(1.f + __expf(-fabsf(z3)))) * 0.0625f;
            });
        }
    }
};
#define SS_RAW [](SS_ARGS) { o0 = a0; o1 = a1; o2 = a2; o3 = a3; }
struct EpiBr1 {
    static constexpr bool STAGED = true;
    const bf16_t* proj;
    bf16_t* y1;
    __device__ __forceinline__ void run(const f32x16 (&acc)[2][4], char* st, int lane, int mrow0, int nbase) const {
        const bf16_t* sp = proj + (size_t)mrow0 * PW + C_MH + nbase;
        bf16_t* dp = y1 + (size_t)mrow0 * 1024 + nbase;
        staged_store(acc, st, lane, SS_RAW, [sp, dp](SG_ARGS) {
            const u32x4 sv = *(const u32x4*)(sp + (size_t)r * PW + c8);
            u32x4 o;
#pragma unroll
            for (int i = 0; i < 4; ++i) o[i] = pk2(bflo(v[i]) * bflo(sv[i]), bfhi(v[i]) * bfhi(sv[i]));
            *(u32x4*)(dp + (size_t)r * 1024 + c8) = o;
        });
    }
};
struct EpiBr2 {
    static constexpr bool STAGED = true;
    const bf16_t* proj;
    const bf16_t* y1;
    bf16_t* y;
    __device__ __forceinline__ void run(const f32x16 (&acc)[2][4], char* st, int lane, int mrow0, int nbase) const {
        const bf16_t* sp = proj + (size_t)mrow0 * PW + C_MG + nbase;
        const bf16_t* yp = y1 + (size_t)mrow0 * 1024 + nbase;
        bf16_t* dp = y + (size_t)mrow0 * 1024 + nbase;
        staged_store(acc, st, lane, SS_RAW, [sp, yp, dp](SG_ARGS) {
            const u32x4 sv = *(const u32x4*)(sp + (size_t)r * PW + c8);
            const u32x4 pv = *(const u32x4*)(yp + (size_t)r * 1024 + c8);
            u32x4 o;
#pragma unroll
            for (int i = 0; i < 4; ++i) o[i] = pk2(bflo(pv[i]) + bflo(v[i]) * bflo(sv[i]), bfhi(pv[i]) + bfhi(v[i]) * bfhi(sv[i]));
            *(u32x4*)(dp + (size_t)r * 1024 + c8) = o;
        });
    }
};
struct EpiOut {
    static constexpr bool STAGED = true;
    const float* x;
    const float* mod;
    float* out;
    int row0;
    __device__ __forceinline__ void run(const f32x16 (&acc)[2][4], char* st, int lane, int mrow0, int nbase) const {
        const int grow0 = row0 + mrow0, b = grow0 >> 11;
        const float* xp = x + (size_t)grow0 * 1024 + nbase;
        const float* gp = mod + (size_t)b * NMOD + 2048 + nbase;
        float* dp = out + (size_t)grow0 * 1024 + nbase;
        staged_store(acc, st, lane, SS_RAW, [xp, gp, dp](SG_ARGS) {
            const float4 x0 = *(const float4*)(xp + (size_t)r * 1024 + c8), x1 = *(const float4*)(xp + (size_t)r * 1024 + c8 + 4);
            const float4 g0 = *(const float4*)(gp + c8), g1 = *(const float4*)(gp + c8 + 4);
            float4 o0, o1;
            o0.x = x0.x + g0.x * bflo(v[0]); o0.y = x0.y + g0.y * bfhi(v[0]); o0.z = x0.z + g0.z * bflo(v[1]); o0.w = x0.w + g0.w * bfhi(v[1]);
            o1.x = x1.x + g1.x * bflo(v[2]); o1.y = x1.y + g1.y * bfhi(v[2]); o1.z = x1.z + g1.z * bflo(v[3]); o1.w = x1.w + g1.w * bfhi(v[3]);
            *(float4*)(dp + (size_t)r * 1024 + c8) = o0;
            *(float4*)(dp + (size_t)r * 1024 + c8 + 4) = o1;
        });
    }
};
struct EpiQ {
    static constexpr bool STAGED = true;
    bf16_t* q;
    __device__ __forceinline__ void run(const f32x16 (&acc)[2][4], char* st, int lane, int mrow0, int nbase) const {
        staged_store_dst(acc, st, lane, q + (size_t)mrow0 * 2048 + nbase, 2048, SS_RAW);
    }
};

__device__ __forceinline__ void transpose_tile(const float* __restrict__ src, int lds_, int srccol0, int k0, bf16_t* __restrict__ dst  , char* smem, const int tid) {
    float* tile = (float*)smem;
    {
        const int r = tid >> 6, c = tid & 63;
#pragma unroll
        for (int p = 0; p < 16; ++p) {
            const int row = p * 4 + r;
            tile[row * 65 + c] = src[(size_t)(k0 + row) * lds_ + srccol0 + c];
        }
    }
    __syncthreads();
    {
        const int n = tid >> 2, ks = (tid & 3) * 16;
        float v[16];
#pragma unroll
        for (int i = 0; i < 16; ++i) v[i] = tile[(ks + i) * 65 + n];
        uint4 o0, o1;
        o0.x = pk2(v[0], v[1]); o0.y = pk2(v[2], v[3]); o0.z = pk2(v[4], v[5]); o0.w = pk2(v[6], v[7]);
        o1.x = pk2(v[8], v[9]); o1.y = pk2(v[10], v[11]); o1.z = pk2(v[12], v[13]); o1.w = pk2(v[14], v[15]);
        bf16_t* d = dst + (size_t)n * 1024 + k0 + ks;
        *(uint4*)d = o0;
        *(uint4*)(d + 8) = o1;
    }
    __syncthreads();
}

__device__ __forceinline__ void phase_prep(const Params& p, char* smem) {
    PHASE_IDS
    smem += half_ * HALF_SMEM;
    constexpr int N_TIN = 16 * 160, N_TBR = 256, N_TQ = 512, N_FOLD = 256, N_MODP = 24 * KSPL, N_CVK = 16, N_CVUV = 8192;
    constexpr int I0 = N_MODP, I1 = I0 + N_TIN, I2 = I1 + 3 * N_TBR, I3 = I2 + N_TQ, I4 = I3 + N_FOLD, I5 = I4 + N_CVK, I6 = I5 + N_CVUV;
    if (bid == 0) {
        float* lb = (float*)(ws + OFF_LB);
        for (int i = tid; i < 2048; i += 256) lb[i] = sigmoidf_(p.lb_logits[i] - p.lb_logits[2048 + i]);
    }
    for (int it = bid; it < I6; it += nblk) {
        if (it < I0) {
            const int cb = it / KSPL, ks = it % KSPL;
            float* s = (float*)smem;
            for (int i = tid; i < 33 * 128; i += 256) {
                const int b = i >> 7, k = i & 127;
                const float cv = (b < 32) ? p.c[b * 1024 + ks * 128 + k] : p.c_ctx[ks * 128 + k];
                s[i] = cv * sigmoidf_(cv);
            }
            __syncthreads();
            float acc[33];
#pragma unroll
            for (int b = 0; b < 33; ++b) acc[b] = 0.f;
            const int j = cb * 256 + tid;
            const float* wp = p.ada_w + (size_t)(ks * 128) * NMOD + j;
            for (int k = 0; k < 128; k += 4) {
                const float w0 = wp[(size_t)(k + 0) * NMOD], w1 = wp[(size_t)(k + 1) * NMOD], w2 = wp[(size_t)(k + 2) * NMOD], w3 = wp[(size_t)(k + 3) * NMOD];
#pragma unroll
                for (int b = 0; b < 33; ++b) {
                    const float4 sv = *(const float4*)(s + b * 128 + k);
                    acc[b] += sv.x * w0 + sv.y * w1 + sv.z * w2 + sv.w * w3;
                }
            }
            float* mp = (float*)(ws + OFF_MODP) + (size_t)ks * 33 * NMOD + j;
#pragma unroll
            for (int b = 0; b < 33; ++b) mp[(size_t)b * NMOD] = acc[b];
            __syncthreads();
        } else if (it < I1) {
            const int r = it - I0, nt = r % 160, kt = r / 160;
            const int n0 = nt * 64;
            const int src0 = n0 < 8192 ? n0 : n0 + 32;
            transpose_tile(p.w_in, DIN, src0, kt * 64, (bf16_t*)(ws + OFF_WIN) + (size_t)n0 * 1024, smem, tid);
        } else if (it < I2) {
            const int r = it - I1, which = r / N_TBR, rr = r % N_TBR, nt = rr % 16, kt = rr / 16;
            const float* src = which == 0 ? p.w_br_hg : (which == 1 ? p.w_br_gla : p.w_out);
            bf16_t* dst = (bf16_t*)(ws + (which == 0 ? OFF_WBRH : (which == 1 ? OFF_WBRG : OFF_WO)));
            transpose_tile(src, 1024, nt * 64, kt * 64, dst + (size_t)(nt * 64) * 1024, smem, tid);
        } else if (it < I3) {
            const int r = it - I2, nt = r % 32, kt = r / 32;
            transpose_tile(p.wq, 2048, nt * 64, kt * 64, (bf16_t*)(ws + OFF_WQ) + (size_t)(nt * 64) * 1024, smem, tid);
        } else if (it < I4) {
            const int r = it - I3, dir = r >> 7, nt = (r >> 4) & 7, kt = r & 15;
            float* sW = (float*)smem;
            float* sG = sW + 64 * 16;
            for (int i = tid; i < 1024; i += 256) {
                const int k = i >> 4, rr = i & 15;
                sW[i] = p.w_in[(size_t)(kt * 64 + k) * DIN + 8192 + 16 * dir + rr];
                const int r2 = i >> 6, n = i & 63;
                sG[i] = p.gk_w[(size_t)dir * 16 * 512 + r2 * 512 + nt * 64 + n];
            }
            __syncthreads();
            const int n = tid >> 2, ks = (tid & 3) * 16;
            float v[16];
#pragma unroll
            for (int i = 0; i < 16; ++i) {
                float a = 0.f;
#pragma unroll
                for (int rr = 0; rr < 16; ++rr) a += sW[(ks + i) * 16 + rr] * sG[rr * 64 + n];
                v[i] = a;
            }
            uint4 o0, o1;
            o0.x = pk2(v[0], v[1]); o0.y = pk2(v[2], v[3]); o0.z = pk2(v[4], v[5]); o0.w = pk2(v[6], v[7]);
            o1.x = pk2(v[8], v[9]); o1.y = pk2(v[10], v[11]); o1.z = pk2(v[12], v[13]); o1.w = pk2(v[14], v[15]);
            bf16_t* d = (bf16_t*)(ws + OFF_WIN) + (size_t)(10240 + dir * 512 + nt * 64 + n) * 1024 + kt * 64 + ks;
            *(uint4*)d = o0;
            *(uint4*)(d + 8) = o1;
            __syncthreads();
        } else if (it < I5) {
            const int r = it - I4;
            const float* src = r < 8 ? p.k1 : p.k2;
            bf16_t* dst = (bf16_t*)(ws + (r < 8 ? OFF_K1 : OFF_K2));
            const size_t e0 = (size_t)(r & 7) * 2048;
            const float4 a = *(const float4*)(src + e0 + tid * 8), b = *(const float4*)(src + e0 + tid * 8 + 4);
            uint4 o;
            o.x = pk2(a.x, a.y); o.y = pk2(a.z, a.w); o.z = pk2(b.x, b.y); o.w = pk2(b.z, b.w);
            *(uint4*)(dst + e0 + tid * 8) = o;
        } else {
            const int r = it - I5, isv = r >= 4096, row = (r & 4095) * 4 + (tid >> 6), lane = tid & 63;
            const float* src = (isv ? p.v : p.u) + (size_t)row * 1024 + lane * 16;
            float4 f[4];
            float am = 0.f;
#pragma unroll
            for (int i = 0; i < 4; ++i) {
                f[i] = *(const float4*)(src + i * 4);
                am = fmaxf(am, fmaxf(fmaxf(fabsf(f[i].x), fabsf(f[i].y)), fmaxf(fabsf(f[i].z), fabsf(f[i].w))));
            }
#pragma unroll
            for (int o = 32; o > 0; o >>= 1) am = fmaxf(am, __shfl_xor(am, o, 64));
            const float sc = am > 0.f ? 384.f / am : 1.f;
            int w4[4];
#pragma unroll
            for (int i = 0; i < 4; ++i) {
                int pk = 0;
                pk = __builtin_amdgcn_cvt_pk_fp8_f32(f[i].x * sc, f[i].y * sc, pk, false);
                pk = __builtin_amdgcn_cvt_pk_fp8_f32(f[i].z * sc, f[i].w * sc, pk, true);
                w4[i] = pk;
            }
            uint4 o;
            o.x = (unsigned)w4[0]; o.y = (unsigned)w4[1]; o.z = (unsigned)w4[2]; o.w = (unsigned)w4[3];
            if (isv) *(uint4*)(ws + OFF_V + (size_t)(lane >> 3) * (16384 * 128) + (size_t)row * 128 + (lane & 7) * 16) = o;
            else *(uint4*)(ws + OFF_U + (size_t)row * 1024 + lane * 16) = o;
            if (lane == 0) ((float*)(ws + (isv ? OFF_VS : OFF_US)))[row] = am > 0.f ? am * (1.f / 384.f) : 1.f;
        }
    }
}

__device__ __forceinline__ void phase_modreduce(const Params& p) {
    PHASE_IDS
    const float* mp = (const float*)(ws + OFF_MODP);
    float* mod = (float*)(ws + OFF_MOD);
    for (int i = bid * 256 + tid; i < 33 * NMOD; i += nblk * 256) {
        float a = p.ada_b[i % NMOD];
#pragma unroll
        for (int ks = 0; ks < KSPL; ++ks) a += mp[(size_t)ks * 33 * NMOD + i];
        mod[i] = a;
    }
}

__device__ __forceinline__ void norm_mod_rows4(const float* __restrict__ xr, const float* __restrict__ g, const float* __restrict__ shift,
                                               const float* __restrict__ scale, bf16_t* __restrict__ dst, int lane) {
    float4 v[4][4];
#pragma unroll
    for (int r = 0; r < 4; ++r)
#pragma unroll
        for (int i = 0; i < 4; ++i) v[r][i] = *(const float4*)(xr + (size_t)r * 1024 + i * 256 + lane * 4);
    float4 gv[4], sh[4], sc[4];
#pragma unroll
    for (int i = 0; i < 4; ++i) {
        const int c = i * 256 + lane * 4;
        gv[i] = *(const float4*)(g + c);
        sh[i] = *(const float4*)(shift + c);
        sc[i] = *(const float4*)(scale + c);
        gv[i].x *= 1.f + sc[i].x; gv[i].y *= 1.f + sc[i].y; gv[i].z *= 1.f + sc[i].z; gv[i].w *= 1.f + sc[i].w;
    }
#pragma unroll
    for (int r = 0; r < 4; ++r) {
        float ss = 0.f;
#pragma unroll
        for (int i = 0; i < 4; ++i) ss += v[r][i].x * v[r][i].x + v[r][i].y * v[r][i].y + v[r][i].z * v[r][i].z + v[r][i].w * v[r][i].w;
        ss = wave_sum(ss);
        const float rstd = rsqrtf(ss * (1.f / 1024.f) + EPS);
#pragma unroll
        for (int i = 0; i < 4; ++i) {
            const int c = i * 256 + lane * 4;
            st_bf4(dst + (size_t)r * 1024 + c, v[r][i].x * rstd * gv[i].x + sh[i].x, v[r][i].y * rstd * gv[i].y + sh[i].y,
                   v[r][i].z * rstd * gv[i].z + sh[i].z, v[r][i].w * rstd * gv[i].w + sh[i].w);
        }
    }
}

__device__ __forceinline__ void phase_hprep(const Params& p, int g) {
    PHASE_IDS
    const int lane = tid & 63, wv = bid * 4 + (tid >> 6), nwv = nblk * 4;
    const float* mod = (const float*)(ws + OFF_MOD);
    bf16_t* h = (bf16_t*)(ws + OFF_H);
    for (int lr = wv * 4; lr < GROWS; lr += nwv * 4) {
        const float* xr;
        int mb;
        if (lr < GLAT) {
            const int b = g * GB + (lr >> 11);
            xr = p.x + ((size_t)b * SEQ + (lr & 2047)) * 1024;
            mb = b;
        } else {
            const int l2 = lr - GLAT, b = g * GB + (l2 >> 8);
            xr = p.ctx + ((size_t)b * CTXL + (l2 & 255)) * 1024;
            mb = 32;
        }
        norm_mod_rows4(xr, p.norm_mix_g, mod + (size_t)mb * NMOD, mod + (size_t)mb * NMOD + 1024, h + (size_t)lr * 1024, lane);
    }
}

__device__ __forceinline__ void phase_h2(const Params& p) {
    PHASE_IDS
    const int lane = tid & 63, wv = bid * 4 + (tid >> 6), nwv = nblk * 4;
    const float* mod = (const float*)(ws + OFF_MOD);
    bf16_t* h2 = (bf16_t*)(ws + OFF_H2);
    for (int r = wv * 4; r < NTOK; r += nwv * 4) {
        const int b = r >> 11;
        norm_mod_rows4(p.out + (size_t)r * 1024, p.norm_ffn_g, mod + (size_t)b * NMOD + 3072, mod + (size_t)b * NMOD + 4096, h2 + (size_t)r * 1024, lane);
    }
}

template <class Skip>
__device__ __forceinline__ bool next_tile(int& v, int tot, int step, int nM, int nN, const Skip& skip, int& pm, int& pn) {
    while (v < tot) {
        if (tile_map(v, nM, nN, pm, pn) && !skip(pm, pn)) return true;
        v += step;
    }
    return false;
}

__device__ __forceinline__ void phase_gemm_in(const Params& p, char* smem) {
    PHASE_IDS_G
    EpiProj epi{(bf16_t*)(ws + OFF_PROJ), (const float*)(ws + OFF_LB), p.gk_b};
    const bf16_t* A = (const bf16_t*)(ws + OFF_H);
    const bf16_t* Bt = (const bf16_t*)(ws + OFF_WIN);
    constexpr int nM = GROWS / 256, nN = NW / 256;
    const int tot = tile_total(nM, nN);
    auto skip = [](int pm, int pn) {
        return pm >= GLAT / 256 && !((pn >= 4 && pn < 16) || (pn >= 22 && pn < 28) || (pn >= 40));
    };
    int v = bid, pm, pn;
    bool have = next_tile(v, tot, nblk, nM, nN, skip, pm, pn), pre = false;
    while (have) {
        int v2 = v + nblk, pm2 = 0, pn2 = 0;
        const bool have2 = next_tile(v2, tot, nblk, nM, nN, skip, pm2, pn2);
        gemm_tile(A, 1024, Bt, 1024, pm, pn, epi, smem, tid, pre, have2 ? (const char*)(A + (size_t)(pm2 * 256) * 1024) : nullptr,
                  have2 ? (const char*)(Bt + (size_t)(pn2 * 256) * 1024) : nullptr);
        pre = have2; have = have2; v = v2; pm = pm2; pn = pn2;
    }
}
__device__ __forceinline__ void phase_branch(const Params& p, char* smem) {
    PHASE_IDS_G
    const bf16_t* proj = (const bf16_t*)(ws + OFF_PROJ);
    bf16_t* y1 = (bf16_t*)(ws + OFF_Y1);
    EpiBr1 e1{proj, y1};
    EpiBr2 e2{proj, y1, (bf16_t*)(ws + OFF_Y)};
    const bf16_t* A1 = (const bf16_t*)(ws + OFF_YN);
    const bf16_t* A2 = A1 + (size_t)GLAT * 1024;
    constexpr int nM = GLAT / 256, nN = 4;
    const int tot = tile_total(nM, nN);
    auto skip = [](int, int) { return false; };
    const bf16_t* W1 = (const bf16_t*)(ws + OFF_WBRH);
    const bf16_t* W2 = (const bf16_t*)(ws + OFF_WBRG);
    int v = bid, pm, pn;
    bool have = next_tile(v, tot, nblk, nM, nN, skip, pm, pn), pre = false;
    while (have) {
        int v2 = v + nblk, pm2 = 0, pn2 = 0;
        const bool have2 = next_tile(v2, tot, nblk, nM, nN, skip, pm2, pn2);
        gemm_tile(A1, 1024, W1, 1024, pm, pn, e1, smem, tid, pre, (const char*)(A2 + (size_t)(pm * 256) * 1024), (const char*)(W2 + (size_t)(pn * 256) * 1024));
        gemm_tile(A2, 1024, W2, 1024, pm, pn, e2, smem, tid, true, have2 ? (const char*)(A1 + (size_t)(pm2 * 256) * 1024) : nullptr,
                  have2 ? (const char*)(W1 + (size_t)(pn2 * 256) * 1024) : nullptr);
        pre = have2; have = have2; v = v2; pm = pm2; pn = pn2;
    }
}
__device__ __forceinline__ void phase_outproj(const Params& p, int g, char* smem) {
    PHASE_IDS_G
    EpiOut e{p.x, (const float*)(ws + OFF_MOD), p.out, g * GLAT};
    constexpr int nM = GLAT / 256, nN = 4;
    const int tot = tile_total(nM, nN);
    auto skip = [](int, int) { return false; };
    const bf16_t* A = (const bf16_t*)(ws + OFF_Y);
    const bf16_t* Bt = (const bf16_t*)(ws + OFF_WO);
    int v = bid, pm, pn;
    bool have = next_tile(v, tot, nblk, nM, nN, skip, pm, pn), pre = false;
    while (have) {
        int v2 = v + nblk, pm2 = 0, pn2 = 0;
        const bool have2 = next_tile(v2, tot, nblk, nM, nN, skip, pm2, pn2);
        gemm_tile(A, 1024, Bt, 1024, pm, pn, e, smem, tid, pre, have2 ? (const char*)(A + (size_t)(pm2 * 256) * 1024) : nullptr,
                  have2 ? (const char*)(Bt + (size_t)(pn2 * 256) * 1024) : nullptr);
        pre = have2; have = have2; v = v2; pm = pm2; pn = pn2;
    }
}
__device__ __forceinline__ void phase_qproj(const Params& p, char* smem) {
    PHASE_IDS_G
    EpiQ e{(bf16_t*)(ws + OFF_Q)};
    constexpr int nM = NTOK / 256, nN = 8;
    const int tot = tile_total(nM, nN);
    auto skip = [](int, int) { return false; };
    const bf16_t* A = (const bf16_t*)(ws + OFF_H2);
    const bf16_t* Bt = (const bf16_t*)(ws + OFF_WQ);
    int v = bid, pm, pn;
    bool have = next_tile(v, tot, nblk, nM, nN, skip, pm, pn), pre = false;
    while (have) {
        int v2 = v + nblk, pm2 = 0, pn2 = 0;
        const bool have2 = next_tile(v2, tot, nblk, nM, nN, skip, pm2, pn2);
        gemm_tile(A, 1024, Bt, 1024, pm, pn, e, smem, tid, pre, have2 ? (const char*)(A + (size_t)(pm2 * 256) * 1024) : nullptr,
                  have2 ? (const char*)(Bt + (size_t)(pn2 * 256) * 1024) : nullptr);
        pre = have2; have = have2; v = v2; pm = pm2; pn = pn2;
    }
}

__device__ __forceinline__ int vtrow(int v) { return (v & ~7) | (((v & 7) + (v >> 3)) & 7); }
__device__ __forceinline__ int swz128(int row, int c16) { return row * 256 + ((c16 ^ (row & 15)) << 4); }

__device__ __forceinline__ void phase_scan(const Params& p, char* smem) {
    PHASE_IDS
    const bf16_t* proj = (const bf16_t*)(ws + OFF_PROJ);
    bf16_t* obase = (bf16_t*)(ws + OFF_O);
    const int lane = tid & 63, w = tid >> 6, l31 = lane & 31, hh = lane >> 5;
    char* sQ = smem;
    char* sK = smem + 16384;
    char* sS = smem + 32768;
    char* sKT = smem + 49152;
    char* sVT = smem + 67584;
    float* sTot = (float*)(smem + 76800);
    float* sF32 = sTot + 256;
    float* sEbr = sF32 + 128;
    float* sEbl = sEbr + 128;
    for (int it = bid; it < 512; it += nblk) {
        const int is_gla = it >> 8, r8 = it & 255;
        int vs, dir, hd, bl, cq, ck, cl, cv, co;
        if (!is_gla) {
            vs = r8 & 1; dir = (r8 >> 1) & 1; hd = (r8 >> 2) & 7; bl = r8 >> 5;
            cq = C_HQ + hd * 128; ck = (dir ? C_HKB : C_HKF) + hd * 128; cl = (dir ? C_HLB : C_HLF) + hd * 128;
            cv = C_HV + hd * 128 + vs * 64; co = hd * 128 + vs * 64;
        } else {
            vs = r8 & 3; dir = (r8 >> 2) & 1; hd = (r8 >> 3) & 3; bl = r8 >> 5;
            cq = C_GQ + hd * 128; ck = C_GK + hd * 128; cl = (dir ? C_GLB : C_GLF) + hd * 128;
            cv = C_GV + hd * 256 + vs * 64; co = hd * 256 + vs * 64;
        }
        bf16_t* odst = obase + (size_t)(is_gla * 2 + dir) * GLAT * 1024;
        f32x16 S[2];
#pragma unroll
        for (int a = 0; a < 2; ++a)
#pragma unroll
            for (int i = 0; i < 16; ++i) S[a][i] = 0.f;
        u32x4 rq[4], rk[4], rl[4], rv[2];
#define ROWOF(step, r) ((step) < 4 ? (GLAT + bl * 256 + (dir ? 255 - ((step) * 64 + (r)) : ((step) * 64 + (r)))) \
                                   : (bl * 2048 + (dir ? 2047 - (((step) - 4) * 64 + (r)) : (((step) - 4) * 64 + (r)))))
#define LOADCHUNK(step)                                                                   \
    {                                                                                     \
        _Pragma("unroll") for (int i = 0; i < 4; ++i) {                                   \
            const int id = tid + i * 256, r = id >> 4, c16 = id & 15;                     \
            const bf16_t* rp = proj + (size_t)ROWOF(step, r) * PW + c16 * 8;              \
            rq[i] = *(const u32x4*)(rp + ((step) >= 4 ? cq : ck));                        \
            rk[i] = *(const u32x4*)(rp + ck);                                             \
            rl[i] = *(const u32x4*)(rp + cl);                                             \
        }                                                                                 \
        _Pragma("unroll") for (int i = 0; i < 2; ++i) {                                   \
            const int id = tid + i * 256, r = id >> 3, c8 = id & 7;                       \
            rv[i] = *(const u32x4*)(proj + (size_t)ROWOF(step, r) * PW + cv + c8 * 8);    \
        }                                                                                 \
    }
        LOADCHUNK(0);
        for (int step = 0; step < 36; ++step) {
            const bool has_q = step >= 4;
#pragma unroll
            for (int i = 0; i < 4; ++i) {
                const int id = tid + i * 256, r = id >> 4, c16 = id & 15;
                const int off = swz128(r, c16);
                if (has_q) *(u32x4*)(sQ + off) = rq[i];
                *(u32x4*)(sK + off) = rk[i];
                *(u32x4*)(sS + off) = rl[i];
            }
#pragma unroll
            for (int i = 0; i < 2; ++i) {
                const int id = tid + i * 256, r = id >> 3, c8 = id & 7;
#pragma unroll
                for (int j = 0; j < 4; ++j) {
                    *(bf16_t*)(sVT + (c8 * 8 + ((2 * j + c8) & 7)) * 144 + r * 2) = (bf16_t)(rv[i][j] & 0xffffu);
                    *(bf16_t*)(sVT + (c8 * 8 + ((2 * j + 1 + c8) & 7)) * 144 + r * 2) = (bf16_t)(rv[i][j] >> 16);
                }
            }
            __syncthreads();
            if (step + 1 < 36) { LOADCHUNK(step + 1); }
            const int c = tid & 127, rh = tid >> 7;
            float lg[32];
            float tot = 0.f;
#pragma unroll
            for (int i = 0; i < 32; ++i) {
                const int r = 32 * rh + i;
                lg[i] = bf2f(*(const bf16_t*)(sS + swz128(r, c >> 3) + (c & 7) * 2));
                tot += lg[i];
            }
            sTot[rh * 128 + c] = tot;
            if (rh == 1) sF32[c] = lg[0];
            __syncthreads();
            {
                const float t0 = sTot[c], bref = t0 + sF32[c], blast = t0 + sTot[128 + c];
                float b = rh ? t0 : 0.f;
                if (rh == 0) {
                    sEbr[c] = __expf(bref);
                    sEbl[c] = __expf(blast - bref);
                }
#pragma unroll
                for (int j4 = 0; j4 < 4; ++j4) {
                    float kmv[8];
#pragma unroll
                    for (int jj = 0; jj < 8; ++jj) {
                        const int i = j4 * 8 + jj, r = 32 * rh + i;
                        b += lg[i];
                        const float e = __expf(b - bref);
                        const float rinv = __builtin_amdgcn_rcpf(e);
                        const int off = swz128(r, c >> 3) + (c & 7) * 2;
                        const float km = bf2f(*(const bf16_t*)(sK + off)) * rinv;
                        kmv[jj] = km;
                        *(bf16_t*)(sK + off) = f2bf(km);
                        if (has_q) {
                            const float qv = bf2f(*(const bf16_t*)(sQ + off));
                            *(bf16_t*)(sQ + off) = f2bf(qv * e);
                        }
                    }
                    uint4 o;
                    o.x = pk2(kmv[0], kmv[1]); o.y = pk2(kmv[2], kmv[3]); o.z = pk2(kmv[4], kmv[5]); o.w = pk2(kmv[6], kmv[7]);
                    *(uint4*)(sKT + c * 144 + (32 * rh + j4 * 8) * 2) = o;
                }
            }
            __syncthreads();
#pragma unroll
            for (int vt = 0; vt < 2; ++vt)
#pragma unroll
                for (int g4 = 0; g4 < 4; ++g4) {
                    const int c0 = 32 * w + 8 * g4 + 4 * hh;
                    const float4 eb = *(const float4*)(sEbr + c0);
                    S[vt][4 * g4 + 0] *= eb.x; S[vt][4 * g4 + 1] *= eb.y; S[vt][4 * g4 + 2] *= eb.z; S[vt][4 * g4 + 3] *= eb.w;
                    if (has_q) {
                        const int vrow = 32 * vt + l31;
                        uint2 o;
                        o.x = pk2(S[vt][4 * g4 + 0], S[vt][4 * g4 + 1]);
                        o.y = pk2(S[vt][4 * g4 + 2], S[vt][4 * g4 + 3]);
                        *(uint2*)(sS + swz128(vrow, c0 >> 3) + (c0 & 7) * 2) = o;
                    }
                }
            if (has_q) {
                const int st = w >> 1, rt = w & 1;
                f32x16 sc;
#pragma unroll
                for (int i = 0; i < 16; ++i) sc[i] = 0.f;
#pragma unroll
                for (int kk = 0; kk < 8; ++kk) {
                    const bf16x8 a = *(const bf16x8*)(sK + swz128(32 * st + l31, kk * 2 + hh));
                    const bf16x8 bq = *(const bf16x8*)(sQ + swz128(32 * rt + l31, kk * 2 + hh));
                    sc = __builtin_amdgcn_mfma_f32_32x32x16_bf16(a, bq, sc, 0, 0, 0);
                }
                __syncthreads();
                {
                    const int r = 32 * rt + l31;
#pragma unroll
                    for (int g4 = 0; g4 < 4; ++g4) {
                        const int s0 = 32 * st + 8 * g4 + 4 * hh;
                        uint2 o;
                        o.x = pk2(r >= s0 + 0 ? sc[4 * g4 + 0] : 0.f, r >= s0 + 1 ? sc[4 * g4 + 1] : 0.f);
                        o.y = pk2(r >= s0 + 2 ? sc[4 * g4 + 2] : 0.f, r >= s0 + 3 ? sc[4 * g4 + 3] : 0.f);
                        *(uint2*)(sK + r * 144 + s0 * 2) = o;
                    }
                }
                __syncthreads();
                {
                    const int vt = w >> 1, rt2 = w & 1;
                    f32x16 oa;
#pragma unroll
                    for (int i = 0; i < 16; ++i) oa[i] = 0.f;
#pragma unroll
                    for (int kk = 0; kk < 4; ++kk) {
                        const bf16x8 a = *(const bf16x8*)(sVT + vtrow(32 * vt + l31) * 144 + (kk * 2 + hh) * 16);
                        const bf16x8 bp = *(const bf16x8*)(sK + (32 * rt2 + l31) * 144 + (kk * 2 + hh) * 16);
                        oa = __builtin_amdgcn_mfma_f32_32x32x16_bf16(a, bp, oa, 0, 0, 0);
                    }
#pragma unroll
                    for (int kk = 0; kk < 8; ++kk) {
                        const bf16x8 a = *(const bf16x8*)(sS + swz128(32 * vt + l31, kk * 2 + hh));
                        const bf16x8 bq = *(const bf16x8*)(sQ + swz128(32 * rt2 + l31, kk * 2 + hh));
                        oa = __builtin_amdgcn_mfma_f32_32x32x16_bf16(a, bq, oa, 0, 0, 0);
                    }
                    const int r = 32 * rt2 + l31;
                    bf16_t* orow = odst + (size_t)ROWOF(step, r) * 1024 + co + 32 * vt + 4 * hh;
#pragma unroll
                    for (int g4 = 0; g4 < 4; ++g4) st_bf4(orow + 8 * g4, oa[4 * g4 + 0], oa[4 * g4 + 1], oa[4 * g4 + 2], oa[4 * g4 + 3]);
                }
            }
#pragma unroll
            for (int vt = 0; vt < 2; ++vt) {
#pragma unroll
                for (int kk = 0; kk < 4; ++kk) {
                    const bf16x8 a = *(const bf16x8*)(sKT + (32 * w + l31) * 144 + (kk * 2 + hh) * 16);
                    const bf16x8 bv = *(const bf16x8*)(sVT + vtrow(32 * vt + l31) * 144 + (kk * 2 + hh) * 16);
                    S[vt] = __builtin_amdgcn_mfma_f32_32x32x16_bf16(a, bv, S[vt], 0, 0, 0);
                }
#pragma unroll
                for (int g4 = 0; g4 < 4; ++g4) {
                    const int c0 = 32 * w + 8 * g4 + 4 * hh;
                    const float4 eb = *(const float4*)(sEbl + c0);
                    S[vt][4 * g4 + 0] *= eb.x; S[vt][4 * g4 + 1] *= eb.y; S[vt][4 * g4 + 2] *= eb.z; S[vt][4 * g4 + 3] *= eb.w;
                }
            }
            __syncthreads();
        }
#undef LOADCHUNK
#undef ROWOF
    }
}

__device__ __forceinline__ void phase_scan2(const Params& p, char* smem) {
    PHASE_IDS_G
    const bf16_t* proj = (const bf16_t*)(ws + OFF_PROJ);
    bf16_t* obase = (bf16_t*)(ws + OFF_O);
    const int lane = tid & 63, w = tid >> 6, l31 = lane & 31, hh = lane >> 5;
    char* sQ = smem;
    char* sK = smem + 16384;
    char* sL = smem + 32768;
    char* sS = smem + 49152;
    char* sKT = smem + 81920;
    char* sVT = smem + 100352;
    float* sTot = (float*)(smem + 118784);
    float* sF32 = sTot + 512;
    float* sEbr = sF32 + 128;
    float* sEbl = sEbr + 128;
    char* sP = smem + 122368;
    for (int it = bid; it < 256; it += nblk) {
        const int is_gla = it >> 7, r7 = it & 127;
        int dir, hd, bl, cq, ck, cl, cv, co;
        if (!is_gla) {
            dir = r7 & 1; hd = (r7 >> 1) & 7; bl = r7 >> 4;
            cq = C_HQ + hd * 128; ck = (dir ? C_HKB : C_HKF) + hd * 128; cl = (dir ? C_HLB : C_HLF) + hd * 128;
            cv = C_HV + hd * 128; co = hd * 128;
        } else {
            const int vs = r7 & 1;
            dir = (r7 >> 1) & 1; hd = (r7 >> 2) & 3; bl = r7 >> 4;
            cq = C_GQ + hd * 128; ck = C_GK + hd * 128; cl = (dir ? C_GLB : C_GLF) + hd * 128;
            cv = C_GV + hd * 256 + vs * 128; co = hd * 256 + vs * 128;
        }
        bf16_t* odst = obase + (size_t)(is_gla * 2 + dir) * GLAT * 1024;
        const int ct = w & 3, vh = w >> 2;
        f32x16 S[2];
#pragma unroll
        for (int a = 0; a < 2; ++a)
#pragma unroll
            for (int i = 0; i < 16; ++i) S[a][i] = 0.f;
        u32x4 rq[2], rk[2], rl[2], rv[2];
#define ROWOF(step, r) ((step) < 4 ? (GLAT + bl * 256 + (dir ? 255 - ((step) * 64 + (r)) : ((step) * 64 + (r)))) \
                                   : (bl * 2048 + (dir ? 2047 - (((step) - 4) * 64 + (r)) : (((step) - 4) * 64 + (r)))))
#define LOADCHUNK(step)                                                                   \
    {                                                                                     \
        _Pragma("unroll") for (int i = 0; i < 2; ++i) {                                   \
            const int id = tid + i * 512, r = id >> 4, c16 = id & 15;                     \
            const bf16_t* rp = proj + (size_t)ROWOF(step, r) * PW + c16 * 8;              \
            rq[i] = *(const u32x4*)(rp + ((step) >= 4 ? cq : ck));                        \
            rk[i] = *(const u32x4*)(rp + ck);                                             \
            rl[i] = *(const u32x4*)(rp + cl);                                             \
            rv[i] = *(const u32x4*)(rp + cv);                                             \
        }                                                                                 \
    }
        LOADCHUNK(0);
        for (int step = 0; step < 36; ++step) {
            const bool has_q = step >= 4;
#pragma unroll
            for (int i = 0; i < 2; ++i) {
                const int id = tid + i * 512, r = id >> 4, c16 = id & 15;
                const int off = swz128(r, c16);
                if (has_q) *(u32x4*)(sQ + off) = rq[i];
                *(u32x4*)(sK + off) = rk[i];
                *(u32x4*)(sL + off) = rl[i];
#pragma unroll
                for (int j = 0; j < 4; ++j) {
                    *(bf16_t*)(sVT + (c16 * 8 + ((2 * j + c16) & 7)) * 144 + r * 2) = (bf16_t)(rv[i][j] & 0xffffu);
                    *(bf16_t*)(sVT + (c16 * 8 + ((2 * j + 1 + c16) & 7)) * 144 + r * 2) = (bf16_t)(rv[i][j] >> 16);
                }
            }
            __syncthreads();
            if (step + 1 < 36) { LOADCHUNK(step + 1); }
            const int c = tid & 127, rg = tid >> 7;
            float lg[16];
            float tot = 0.f;
#pragma unroll
            for (int i = 0; i < 16; ++i) {
                const int r = 16 * rg + i;
                lg[i] = bf2f(*(const bf16_t*)(sL + swz128(r, c >> 3) + (c & 7) * 2));
                tot += lg[i];
            }
            sTot[rg * 128 + c] = tot;
            if (rg == 2) sF32[c] = lg[0];
            __syncthreads();
            {
                const float t0 = sTot[c], t1 = sTot[128 + c], t2 = sTot[256 + c], t3 = sTot[384 + c];
                const float bref = t0 + t1 + sF32[c], blast = t0 + t1 + t2 + t3;
                float b = (rg > 0 ? t0 : 0.f) + (rg > 1 ? t1 : 0.f) + (rg > 2 ? t2 : 0.f);
                if (rg == 0) {
                    sEbr[c] = __expf(bref);
                    sEbl[c] = __expf(blast - bref);
                }
#pragma unroll
                for (int j4 = 0; j4 < 2; ++j4) {
                    float kmv[8];
#pragma unroll
                    for (int jj = 0; jj < 8; ++jj) {
                        const int i = j4 * 8 + jj, r = 16 * rg + i;
                        b += lg[i];
                        const float e = __expf(b - bref);
                        const float rinv = __builtin_amdgcn_rcpf(e);
                        const int off = swz128(r, c >> 3) + (c & 7) * 2;
                        const float km = bf2f(*(const bf16_t*)(sK + off)) * rinv;
                        kmv[jj] = km;
                        *(bf16_t*)(sK + off) = f2bf(km);
                        if (has_q) {
                            const float qv = bf2f(*(const bf16_t*)(sQ + off));
                            *(bf16_t*)(sQ + off) = f2bf(qv * e);
                        }
                    }
                    uint4 o;
                    o.x = pk2(kmv[0], kmv[1]); o.y = pk2(kmv[2], kmv[3]); o.z = pk2(kmv[4], kmv[5]); o.w = pk2(kmv[6], kmv[7]);
                    *(uint4*)(sKT + c * 144 + (16 * rg + j4 * 8) * 2) = o;
                }
            }
            __syncthreads();
#pragma unroll
            for (int vt = 0; vt < 2; ++vt)
#pragma unroll
                for (int g4 = 0; g4 < 4; ++g4) {
                    const int c0 = 32 * ct + 8 * g4 + 4 * hh;
                    const float4 eb = *(const float4*)(sEbr + c0);
                    S[vt][4 * g4 + 0] *= eb.x; S[vt][4 * g4 + 1] *= eb.y; S[vt][4 * g4 + 2] *= eb.z; S[vt][4 * g4 + 3] *= eb.w;
                    if (has_q) {
                        const int vrow = 64 * vh + 32 * vt + l31;
                        uint2 o;
                        o.x = pk2(S[vt][4 * g4 + 0], S[vt][4 * g4 + 1]);
                        o.y = pk2(S[vt][4 * g4 + 2], S[vt][4 * g4 + 3]);
                        *(uint2*)(sS + swz128(vrow, c0 >> 3) + (c0 & 7) * 2) = o;
                    }
                }
            if (has_q) {
                f32x16 sc;
#pragma unroll
                for (int i = 0; i < 16; ++i) sc[i] = 0.f;
                const int st = (w >> 1) & 1, rt = w & 1;
                if (w < 4) {
#pragma unroll
                    for (int kk = 0; kk < 8; ++kk) {
                        const bf16x8 a = *(const bf16x8*)(sK + swz128(32 * st + l31, kk * 2 + hh));
                        const bf16x8 bq = *(const bf16x8*)(sQ + swz128(32 * rt + l31, kk * 2 + hh));
                        sc = __builtin_amdgcn_mfma_f32_32x32x16_bf16(a, bq, sc, 0, 0, 0);
                    }
                }
                if (w < 4) {
                    const int r = 32 * rt + l31;
#pragma unroll
                    for (int g4 = 0; g4 < 4; ++g4) {
                        const int s0 = 32 * st + 8 * g4 + 4 * hh;
                        uint2 o;
                        o.x = pk2(r >= s0 + 0 ? sc[4 * g4 + 0] : 0.f, r >= s0 + 1 ? sc[4 * g4 + 1] : 0.f);
                        o.y = pk2(r >= s0 + 2 ? sc[4 * g4 + 2] : 0.f, r >= s0 + 3 ? sc[4 * g4 + 3] : 0.f);
                        *(uint2*)(sP + r * 144 + s0 * 2) = o;
                    }
                }
                __syncthreads();
                {
                    const int vt4 = w >> 1, rt2 = w & 1;
                    f32x16 oa;
#pragma unroll
                    for (int i = 0; i < 16; ++i) oa[i] = 0.f;
#pragma unroll
                    for (int kk = 0; kk < 4; ++kk) {
                        const bf16x8 a = *(const bf16x8*)(sVT + vtrow(32 * vt4 + l31) * 144 + (kk * 2 + hh) * 16);
                        const bf16x8 bp = *(const bf16x8*)(sP + (32 * rt2 + l31) * 144 + (kk * 2 + hh) * 16);
                        oa = __builtin_amdgcn_mfma_f32_32x32x16_bf16(a, bp, oa, 0, 0, 0);
                    }
#pragma unroll
                    for (int kk = 0; kk < 8; ++kk) {
                        const bf16x8 a = *(const bf16x8*)(sS + swz128(32 * vt4 + l31, kk * 2 + hh));
                        const bf16x8 bq = *(const bf16x8*)(sQ + swz128(32 * rt2 + l31, kk * 2 + hh));
                        oa = __builtin_amdgcn_mfma_f32_32x32x16_bf16(a, bq, oa, 0, 0, 0);
                    }
                    const int r = 32 * rt2 + l31;
                    bf16_t* orow = odst + (size_t)ROWOF(step, r) * 1024 + co + 32 * vt4 + 4 * hh;
#pragma unroll
                    for (int g4 = 0; g4 < 4; ++g4) st_bf4(orow + 8 * g4, oa[4 * g4 + 0], oa[4 * g4 + 1], oa[4 * g4 + 2], oa[4 * g4 + 3]);
                }
            }
#pragma unroll
            for (int vt = 0; vt < 2; ++vt) {
#pragma unroll
                for (int kk = 0; kk < 4; ++kk) {
                    const bf16x8 a = *(const bf16x8*)(sKT + (32 * ct + l31) * 144 + (kk * 2 + hh) * 16);
                    const bf16x8 bv = *(const bf16x8*)(sVT + vtrow(64 * vh + 32 * vt + l31) * 144 + (kk * 2 + hh) * 16);
                    S[vt] = __builtin_amdgcn_mfma_f32_32x32x16_bf16(a, bv, S[vt], 0, 0, 0);
                }
#pragma unroll
                for (int g4 = 0; g4 < 4; ++g4) {
                    const int c0 = 32 * ct + 8 * g4 + 4 * hh;
                    const float4 eb = *(const float4*)(sEbl + c0);
                    S[vt][4 * g4 + 0] *= eb.x; S[vt][4 * g4 + 1] *= eb.y; S[vt][4 * g4 + 2] *= eb.z; S[vt][4 * g4 + 3] *= eb.w;
                }
            }
            __syncthreads();
        }
#undef LOADCHUNK
#undef ROWOF
    }
}

__device__ __forceinline__ void phase_headnorm(const Params& p) {
    PHASE_IDS
    const int lane = tid & 63, wv = bid * 4 + (tid >> 6), nwv = nblk * 4;
    const bf16_t* proj = (const bf16_t*)(ws + OFF_PROJ);
    const bf16_t* ob = (const bf16_t*)(ws + OFF_O);
    bf16_t* yn = (bf16_t*)(ws + OFF_YN);
    constexpr int R = 4;
    for (int job = wv * R; job < 2 * GLAT; job += nwv * R) {
        const int gla = job >= GLAT, lr0 = job - gla * GLAT;
        const float* gp = (gla ? p.gla_norm_g : p.hg_norm_g) + ((lane * 16) & (gla ? 255 : 127));
        u32x4 a[R][2], bq[R][2], sq[R][2];
#pragma unroll
        for (int r = 0; r < R; ++r) {
            const bf16_t* of = ob + (size_t)(gla * 2) * GLAT * 1024 + (size_t)(lr0 + r) * 1024 + lane * 16;
            const bf16_t* obw = of + (size_t)GLAT * 1024;
            const bf16_t* sgp = proj + (size_t)(lr0 + r) * PW + (gla ? C_GSG : C_HSG) + lane * 16;
#pragma unroll
            for (int hblk = 0; hblk < 2; ++hblk) {
                a[r][hblk] = *(const u32x4*)(of + hblk * 8);
                bq[r][hblk] = *(const u32x4*)(obw + hblk * 8);
                sq[r][hblk] = *(const u32x4*)(sgp + hblk * 8);
            }
        }
        float gf[16];
#pragma unroll
        for (int i = 0; i < 16; ++i) gf[i] = gp[i];
#pragma unroll
        for (int r = 0; r < R; ++r) {
            float o[16], sg[16];
#pragma unroll
            for (int hblk = 0; hblk < 2; ++hblk)
#pragma unroll
                for (int j = 0; j < 4; ++j) {
                    o[hblk * 8 + 2 * j] = bflo(a[r][hblk][j]) + bflo(bq[r][hblk][j]);
                    o[hblk * 8 + 2 * j + 1] = bfhi(a[r][hblk][j]) + bfhi(bq[r][hblk][j]);
                    sg[hblk * 8 + 2 * j] = bflo(sq[r][hblk][j]);
                    sg[hblk * 8 + 2 * j + 1] = bfhi(sq[r][hblk][j]);
                }
            float ss = 0.f;
#pragma unroll
            for (int i = 0; i < 16; ++i) ss += o[i] * o[i];
            ss += __shfl_xor(ss, 1, 64);
            ss += __shfl_xor(ss, 2, 64);
            ss += __shfl_xor(ss, 4, 64);
            if (gla) ss += __shfl_xor(ss, 8, 64);
            const float rstd = rsqrtf(ss * (gla ? (1.f / 256.f) : (1.f / 128.f)) + EPS);
            float y[16];
#pragma unroll
            for (int i = 0; i < 16; ++i) y[i] = o[i] * rstd * gf[i] * sg[i];
            bf16_t* d = yn + (size_t)gla * GLAT * 1024 + (size_t)(lr0 + r) * 1024 + lane * 16;
            uint4 o0, o1;
            o0.x = pk2(y[0], y[1]); o0.y = pk2(y[2], y[3]); o0.z = pk2(y[4], y[5]); o0.w = pk2(y[6], y[7]);
            o1.x = pk2(y[8], y[9]); o1.y = pk2(y[10], y[11]); o1.z = pk2(y[12], y[13]); o1.w = pk2(y[14], y[15]);
            *(uint4*)d = o0;
            *(uint4*)(d + 8) = o1;
        }
    }
}

__device__ __forceinline__ unsigned f2key(float f) {
    const unsigned u = __float_as_uint(f);
    return u ^ ((u >> 31) ? 0xffffffffu : 0x80000000u);
}
__device__ __forceinline__ float key2f(unsigned k) {
    const unsigned u = (k >> 31) ? (k ^ 0x80000000u) : ~k;
    return __uint_as_float(u);
}
#define TOPK_INSERT(arr, x)                        \
    {                                              \
        unsigned x_ = (x);                         \
        _Pragma("unroll") for (int q_ = 0; q_ < 16; ++q_) { \
            const unsigned hi_ = max(arr[q_], x_); \
            x_ = min(arr[q_], x_);                 \
            arr[q_] = hi_;                         \
        }                                          \
    }

template <int N>
__device__ __forceinline__ void bitonic_sort_desc(unsigned (&a)[N], const int base) {
#pragma unroll
    for (int k = 2; k <= 16; k <<= 1)
#pragma unroll
        for (int j = k >> 1; j > 0; j >>= 1)
#pragma unroll
            for (int i = 0; i < 16; ++i) {
                const int l = i ^ j;
                if (l > i) {
                    const bool desc = ((i & k) == 0);
                    const unsigned hi = max(a[base + i], a[base + l]), lo = min(a[base + i], a[base + l]);
                    a[base + i] = desc ? hi : lo;
                    a[base + l] = desc ? lo : hi;
                }
            }
}
template <int N, int M>
__device__ __forceinline__ void merge_top16(unsigned (&a)[N], const int ba, const unsigned (&b)[M], const int bb) {
#pragma unroll
    for (int i = 0; i < 16; ++i) a[ba + i] = max(a[ba + i], b[bb + 15 - i]);
#pragma unroll
    for (int j = 8; j > 0; j >>= 1)
#pragma unroll
        for (int i = 0; i < 16; ++i) {
            const int l = i ^ j;
            if (l > i) {
                const unsigned hi = max(a[ba + i], a[ba + l]), lo = min(a[ba + i], a[ba + l]);
                a[ba + i] = hi;
                a[ba + l] = lo;
            }
        }
}
__device__ __forceinline__ void top16_of_64(unsigned (&k)[64]) {
    bitonic_sort_desc(k, 0);
    bitonic_sort_desc(k, 16);
    bitonic_sort_desc(k, 32);
    bitonic_sort_desc(k, 48);
    merge_top16(k, 0, k, 16);
    merge_top16(k, 32, k, 48);
    merge_top16(k, 0, k, 32);
}

__device__ __forceinline__ void peer_u_range(const Params& p, char* ws, const int lane, const int tok_begin, const int tok_end, const int tok_step);

__device__ __forceinline__ void phase_topk(const Params& p, char* smem) {
    PHASE_IDS
    smem += half_ * HALF_SMEM;
    const bf16_t* q = (const bf16_t*)(ws + OFF_Q);
    const bf16_t* k1 = (const bf16_t*)(ws + OFF_K1);
    const bf16_t* k2 = (const bf16_t*)(ws + OFF_K2);
    int* sidx = (int*)(ws + OFF_SIDX);
    float* sgate = (float*)(ws + OFF_SGATE);
    float* sc = (float*)smem;
    unsigned* sM = (unsigned*)(smem + 128 * 130 * 4);
    const int lane = tid & 63, w = tid >> 6, l31 = lane & 31, hh = lane >> 5;
    for (int tb = bid; tb < 1024; tb += nblk) {
      for (int hd = 0; hd < 8; ++hd) {
        {
            const int side = w >> 1, th = w & 1;
            const bf16_t* qrow = q + (size_t)(tb * 64 + th * 32 + l31) * 2048 + hd * 256 + side * 128 + 8 * hh;
            const bf16_t* kb = (side ? k2 : k1) + (size_t)l31 * 128 + 8 * hh;
            bf16x8 fa[8];
#pragma unroll
            for (int kk = 0; kk < 8; ++kk) fa[kk] = *(const bf16x8*)(qrow + kk * 16);
#pragma unroll
            for (int nt = 0; nt < 4; ++nt) {
                f32x16 acc;
#pragma unroll
                for (int i = 0; i < 16; ++i) acc[i] = 0.f;
                bf16x8 fb[8];
#pragma unroll
                for (int kk = 0; kk < 8; ++kk) fb[kk] = *(const bf16x8*)(kb + (size_t)(nt * 32) * 128 + kk * 16);
                __builtin_amdgcn_sched_barrier(0);
#pragma unroll
                for (int kk = 0; kk < 8; ++kk) acc = __builtin_amdgcn_mfma_f32_32x32x16_bf16(fa[kk], fb[kk], acc, 0, 0, 0);
                const int key = nt * 32 + l31;
                const int kpos = (key >> 6) * 65 + (key & 63);
#pragma unroll
                for (int i = 0; i < 16; ++i) {
                    const int tok = th * 32 + (i & 3) + 8 * (i >> 2) + 4 * hh;
                    sc[(side * 64 + tok) * 130 + kpos] = acc[i];
                }
            }
        }
        __syncthreads();
        unsigned a[64];
        {
            const int row = tid >> 1, half = tid & 1;
            const float* sp = sc + row * 130 + half * 65;
#pragma unroll
            for (int j = 0; j < 64; ++j) a[j] = (f2key(sp[j]) & ~127u) | (unsigned)(127 - (half * 64 + j));
            top16_of_64(a);
            if (half) {
#pragma unroll
                for (int i = 0; i < 16; ++i) sM[row * 16 + i] = a[i];
            }
        }
        __syncthreads();
        if (!(tid & 1)) {
            const int row = tid >> 1;
            unsigned b[16];
#pragma unroll
            for (int i = 0; i < 16; ++i) b[i] = sM[row * 16 + i];
            merge_top16(a, 0, b, 0);
        }
        __syncthreads();
        if (!(tid & 1)) {
            const int row = tid >> 1;
#pragma unroll
            for (int i = 0; i < 16; ++i) sM[row * 16 + i] = a[i];
        }
        __syncthreads();
        if (tid < 64) {
            const int t = tid;
            float v1[16], v2[16];
#pragma unroll
            for (int i = 0; i < 16; ++i) {
                v1[i] = key2f(sM[t * 16 + i] & ~127u);
                v2[i] = key2f(sM[(64 + t) * 16 + i] & ~127u);
            }
            unsigned cnd[64];
            {
                int n = 0;
#pragma unroll
                for (int i = 0; i < 16; ++i)
#pragma unroll
                    for (int j = 0; j < 16; ++j)
                        if ((i + 1) * (j + 1) <= 16) {
                            cnd[n] = (f2key(v1[i] + v2[j]) & ~255u) | (unsigned)(255 - (i * 16 + j));
                            ++n;
                        }
#pragma unroll
                for (int q = 50; q < 64; ++q) cnd[q] = 0u;
            }
            top16_of_64(cnd);
            float sv[16], mx, sum = 0.f;
            mx = key2f(cnd[0] & ~255u);
#pragma unroll
            for (int i = 0; i < 16; ++i) {
                sv[i] = __expf(key2f(cnd[i] & ~255u) - mx);
                sum += sv[i];
            }
            const float inv = 1.f / sum;
            const size_t ob = (size_t)(tb * 64 + t) * 128 + hd * 16;
#pragma unroll
            for (int i = 0; i < 16; ++i) {
                const int code = 255 - (int)(cnd[i] & 255u);
                const int i1 = 127 - (int)(sM[t * 16 + (code >> 4)] & 127u);
                const int i2 = 127 - (int)(sM[(64 + t) * 16 + (code & 15)] & 127u);
                sidx[ob + i] = i1 * 128 + i2;
                sgate[ob + i] = sv[i] * inv;
            }
        }
        __syncthreads();
      }
      __threadfence_block();
      __syncthreads();
      peer_u_range(p, ws, lane, tb * 64 + w * 16, tb * 64 + w * 16 + 16, 1);
    }
}

__device__ __forceinline__ void peer_u_range(const Params& p, char* ws, const int lane, const int tok_begin, const int tok_end, const int tok_step) {
    const bf16_t* h2 = (const bf16_t*)(ws + OFF_H2);
    const char* U = ws + OFF_U;
    const float* US = (const float*)(ws + OFF_US);
    const float* VS = (const float*)(ws + OFF_VS);
    const int* sidx = (const int*)(ws + OFF_SIDX);
    const float* sgate = (const float*)(ws + OFF_SGATE);
    float* wbuf = (float*)(ws + OFF_PW);
    const int jl = ((lane >> 5) & 1) * 4 + ((lane >> 4) & 1) * 2 + ((lane >> 3) & 1);
    int tok = tok_begin;
    u32x4 xa, xb;
    int id0 = 0, id1 = 0;
    float g0 = 0.f, g1 = 0.f;
    xa = xb = (u32x4){0u, 0u, 0u, 0u};
    if (tok < tok_end) {
        xa = *(const u32x4*)(h2 + (size_t)tok * 1024 + lane * 16);
        xb = *(const u32x4*)(h2 + (size_t)tok * 1024 + lane * 16 + 8);
        id0 = sidx[(size_t)tok * 128 + lane]; id1 = sidx[(size_t)tok * 128 + 64 + lane];
        g0 = sgate[(size_t)tok * 128 + lane]; g1 = sgate[(size_t)tok * 128 + 64 + lane];
    }
    for (; tok < tok_end; tok += tok_step) {
        fv2_t xp[8];
#pragma unroll
        for (int i = 0; i < 4; ++i) {
            xp[i] = (fv2_t){bflo(xa[i]), bfhi(xa[i])};
            xp[4 + i] = (fv2_t){bflo(xb[i]), bfhi(xb[i])};
        }
        const float us0 = US[id0], us1 = US[id1];
        const float gv0 = g0 * VS[id0], gv1 = g1 * VS[id1];
        const int cid0 = id0, cid1 = id1;
        const int tn = tok + tok_step;
        if (tn < tok_end) {
            xa = *(const u32x4*)(h2 + (size_t)tn * 1024 + lane * 16);
            xb = *(const u32x4*)(h2 + (size_t)tn * 1024 + lane * 16 + 8);
            id0 = sidx[(size_t)tn * 128 + lane]; id1 = sidx[(size_t)tn * 128 + 64 + lane];
            g0 = sgate[(size_t)tn * 128 + lane]; g1 = sgate[(size_t)tn * 128 + 64 + lane];
        }
        float wout0 = 0.f, wout1 = 0.f;
#pragma unroll 1
        for (int e0 = 0; e0 < 128; e0 += 16) {
            const int idsel = e0 < 64 ? cid0 : cid1;
            const float ussel = e0 < 64 ? us0 : us1, gvsel = e0 < 64 ? gv0 : gv1;
            const int eb = e0 & 63;
            u32x4 ur[16];
#pragma unroll
            for (int j = 0; j < 16; ++j) {
                const int eid = __builtin_amdgcn_readlane(idsel, eb + j);
                ur[j] = *(const u32x4*)(U + (size_t)eid * 1024 + lane * 16);
            }
#pragma unroll
            for (int hb = 0; hb < 2; ++hb) {
                float d[8];
#pragma unroll
                for (int j = 0; j < 8; ++j) {
                    fv2_t a2 = {0.f, 0.f};
#pragma unroll
                    for (int i = 0; i < 4; ++i) {
                        const fv2_t lo = __builtin_amdgcn_cvt_pk_f32_fp8((int)ur[hb * 8 + j][i], false);
                        const fv2_t hi = __builtin_amdgcn_cvt_pk_f32_fp8((int)ur[hb * 8 + j][i], true);
                        a2 = __builtin_elementwise_fma(lo, xp[2 * i], a2);
                        a2 = __builtin_elementwise_fma(hi, xp[2 * i + 1], a2);
                    }
                    d[j] = a2.x + a2.y;
                }
                float t4[4], t2[2], t1;
                {
                    const bool up = (lane & 32) != 0;
#pragma unroll
                    for (int i = 0; i < 4; ++i) {
                        const float keep = up ? d[4 + i] : d[i], send = up ? d[i] : d[4 + i];
                        t4[i] = keep + __shfl_xor(send, 32, 64);
                    }
                }
                {
                    const bool up = (lane & 16) != 0;
#pragma unroll
                    for (int i = 0; i < 2; ++i) {
                        const float keep = up ? t4[2 + i] : t4[i], send = up ? t4[i] : t4[2 + i];
                        t2[i] = keep + __shfl_xor(send, 16, 64);
                    }
                }
                {
                    const bool up = (lane & 8) != 0;
                    const float keep = up ? t2[1] : t2[0], send = up ? t2[0] : t2[1];
                    t1 = keep + __shfl_xor(send, 8, 64);
                }
                t1 += __shfl_xor(t1, 4, 64);
                t1 += __shfl_xor(t1, 2, 64);
                t1 += __shfl_xor(t1, 1, 64);
                const float uscl = __shfl(ussel, eb + hb * 8 + jl, 64), gvl = __shfl(gvsel, eb + hb * 8 + jl, 64);
                const float z = t1 * uscl;
                const float wl = gvl * 0.5f * z * (1.f + erff(z * 0.70710678118654752f));
                const int jj = (lane - eb - hb * 8) & 7;
                const int srcl = ((jj >> 2) & 1) * 32 + ((jj >> 1) & 1) * 16 + (jj & 1) * 8;
                const float wv_ = __shfl(wl, srcl, 64);
                const bool mine = (lane >= eb + hb * 8) && (lane < eb + hb * 8 + 8);
                if (e0 < 64) wout0 = mine ? wv_ : wout0;
                else wout1 = mine ? wv_ : wout1;
            }
        }
        wbuf[(size_t)tok * 128 + lane] = wout0;
        wbuf[(size_t)tok * 128 + 64 + lane] = wout1;
    }
}

__device__ __forceinline__ void phase_peer_v(const Params& p, char* smem) {
    PHASE_IDS_G
    const int lane = tid & 63, w = tid >> 6;
    unsigned* xcnt = (unsigned*)(ws + OFF_BAR) + 3584;
    const unsigned myx = ((volatile unsigned*)(smem + 2 * HALF_SMEM))[2], myrank = ((volatile unsigned*)(smem + 2 * HALF_SMEM))[3];
    unsigned nx = 0, myidx = 0, nloc = 1;
    for (unsigned j = 0; j < 16; ++j) {
        const unsigned c = __hip_atomic_load(xcnt + j, __ATOMIC_RELAXED, __HIP_MEMORY_SCOPE_AGENT);
        if (c > 0) {
            if (j == myx) { myidx = nx; nloc = c; }
            ++nx;
        }
    }
    const char* V = ws + OFF_V;
    const int* sidx = (const int*)(ws + OFF_SIDX);
    const float* W = (const float*)(ws + OFF_PW);
    bf16_t* pbuf = (bf16_t*)(ws + OFF_Q);
    const int colo = (lane & 7) * 16 + ((lane >> 5) & 1) * 8 + ((lane >> 4) & 1) * 4 + ((lane >> 3) & 1) * 2;
    for (unsigned part = myidx; part < 8; part += nx) {
        const int tstep = (int)(nloc * 8);
        int tok = (int)(myrank * 8 + w);
        int id0 = 0, id1 = 0;
        float w0 = 0.f, w1 = 0.f;
        if (tok < NTOK) {
            id0 = sidx[(size_t)tok * 128 + lane]; id1 = sidx[(size_t)tok * 128 + 64 + lane];
            w0 = W[(size_t)tok * 128 + lane]; w1 = W[(size_t)tok * 128 + 64 + lane];
        }
        for (; tok < NTOK; tok += tstep) {
            const int tn = tok + tstep;
            int nid0 = 0, nid1 = 0;
            float nw0 = 0.f, nw1 = 0.f;
            if (tn < NTOK) {
                nid0 = sidx[(size_t)tn * 128 + lane]; nid1 = sidx[(size_t)tn * 128 + 64 + lane];
                nw0 = W[(size_t)tn * 128 + lane]; nw1 = W[(size_t)tn * 128 + 64 + lane];
            }
            fv2_t acc2[8];
#pragma unroll
            for (int i = 0; i < 8; ++i) acc2[i] = (fv2_t){0.f, 0.f};
#pragma unroll 1
            for (int hb = 0; hb < 2; ++hb) {
                const int idsel = hb ? id1 : id0;
                const float wsel = hb ? w1 : w0;
                u32x4 vv[8];
                float wg[8];
#pragma unroll
                for (int bt = 0; bt < 8; ++bt) {
                    const int slot = bt * 8 + (lane >> 3);
                    const int eid = __shfl(idsel, slot, 64);
                    wg[bt] = __shfl(wsel, slot, 64);
                    vv[bt] = *(const u32x4*)(V + (size_t)part * (16384 * 128) + (size_t)eid * 128 + (lane & 7) * 16);
                }
#pragma unroll
                for (int bt = 0; bt < 8; ++bt) {
#pragma unroll
                    for (int i = 0; i < 4; ++i) {
                        const fv2_t lo = __builtin_amdgcn_cvt_pk_f32_fp8((int)vv[bt][i], false);
                        const fv2_t hi = __builtin_amdgcn_cvt_pk_f32_fp8((int)vv[bt][i], true);
                        const fv2_t w2 = {wg[bt], wg[bt]};
                        acc2[2 * i] = __builtin_elementwise_fma(w2, lo, acc2[2 * i]);
                        acc2[2 * i + 1] = __builtin_elementwise_fma(w2, hi, acc2[2 * i + 1]);
                    }
                }
            }
            float acc[16];
#pragma unroll
            for (int i = 0; i < 8; ++i) { acc[2 * i] = acc2[i].x; acc[2 * i + 1] = acc2[i].y; }
            float t8[8], t4[4], t2[2];
            {
                const bool up = (lane & 32) != 0;
#pragma unroll
                for (int i = 0; i < 8; ++i) {
                    const float keep = up ? acc[8 + i] : acc[i], send = up ? acc[i] : acc[8 + i];
                    t8[i] = keep + __shfl_xor(send, 32, 64);
                }
            }
            {
                const bool up = (lane & 16) != 0;
#pragma unroll
                for (int i = 0; i < 4; ++i) {
                    const float keep = up ? t8[4 + i] : t8[i], send = up ? t8[i] : t8[4 + i];
                    t4[i] = keep + __shfl_xor(send, 16, 64);
                }
            }
            {
                const bool up = (lane & 8) != 0;
#pragma unroll
                for (int i = 0; i < 2; ++i) {
                    const float keep = up ? t4[2 + i] : t4[i], send = up ? t4[i] : t4[2 + i];
                    t2[i] = keep + __shfl_xor(send, 8, 64);
                }
            }
            *(unsigned*)(pbuf + (size_t)tok * 1024 + (int)part * 128 + colo) = pk2(t2[0], t2[1]);
            id0 = nid0; id1 = nid1; w0 = nw0; w1 = nw1;
        }
    }
}

__device__ __forceinline__ void phase_final(const Params& p) {
    PHASE_IDS
    const int lane = tid & 63, wv = bid * 4 + (tid >> 6), nwv = nblk * 4;
    const bf16_t* pbuf = (const bf16_t*)(ws + OFF_Q);
    const float* mod = (const float*)(ws + OFF_MOD);
    float4 fg[4];
#pragma unroll
    for (int hq = 0; hq < 4; ++hq) fg[hq] = *(const float4*)(p.final_g + (hq >> 1) * 512 + lane * 8 + (hq & 1) * 4);
    constexpr int R = 2;
    for (int tok = wv * R; tok < NTOK; tok += nwv * R) {
        const float* g2 = mod + (size_t)(tok >> 11) * NMOD + 5120;
        float4 xv[R][4];
        u32x4 pv[R][2];
#pragma unroll
        for (int r = 0; r < R; ++r) {
            const float* orow = p.out + (size_t)(tok + r) * 1024;
#pragma unroll
            for (int hq = 0; hq < 4; ++hq) xv[r][hq] = *(const float4*)(orow + (hq >> 1) * 512 + lane * 8 + (hq & 1) * 4);
            pv[r][0] = *(const u32x4*)(pbuf + (size_t)(tok + r) * 1024 + lane * 8);
            pv[r][1] = *(const u32x4*)(pbuf + (size_t)(tok + r) * 1024 + 512 + lane * 8);
        }
        float4 gv[4];
#pragma unroll
        for (int hq = 0; hq < 4; ++hq) gv[hq] = *(const float4*)(g2 + (hq >> 1) * 512 + lane * 8 + (hq & 1) * 4);
#pragma unroll
        for (int r = 0; r < R; ++r) {
            float4 x2[4];
            float ss = 0.f;
#pragma unroll
            for (int hq = 0; hq < 4; ++hq) {
                const unsigned u0 = pv[r][hq >> 1][(hq & 1) * 2], u1 = pv[r][hq >> 1][(hq & 1) * 2 + 1];
                x2[hq].x = xv[r][hq].x + gv[hq].x * bflo(u0);
                x2[hq].y = xv[r][hq].y + gv[hq].y * bfhi(u0);
                x2[hq].z = xv[r][hq].z + gv[hq].z * bflo(u1);
                x2[hq].w = xv[r][hq].w + gv[hq].w * bfhi(u1);
                ss += x2[hq].x * x2[hq].x + x2[hq].y * x2[hq].y + x2[hq].z * x2[hq].z + x2[hq].w * x2[hq].w;
            }
            ss = wave_sum(ss);
            const float rs = rsqrtf(ss * (1.f / 1024.f) + EPS);
            float* orow = p.out + (size_t)(tok + r) * 1024;
#pragma unroll
            for (int hq = 0; hq < 4; ++hq) {
                float4 o;
                o.x = x2[hq].x * rs * fg[hq].x; o.y = x2[hq].y * rs * fg[hq].y; o.z = x2[hq].z * rs * fg[hq].z; o.w = x2[hq].w * rs * fg[hq].w;
                *(float4*)(orow + (hq >> 1) * 512 + lane * 8 + (hq & 1) * 4) = o;
            }
        }
    }
}

#ifndef DBG
#define DBG 0
#ifndef DUP
#define DUP 0
#endif
#endif
__device__ __forceinline__ void phase_dump(const Params& p) {
    PHASE_IDS
    for (size_t i = (size_t)bid * 256 + tid; i < (size_t)NTOK * 1024; i += (size_t)nblk * 256) {
        float v = 0.f;
        if (DBG == 1) {
            if (i < 33 * NMOD) v = ((const float*)(ws + OFF_MOD))[i];
            else v = bf2f(((const bf16_t*)ws)[i]);
        } else if (DBG == 2) {
            const size_t row = (i >> 12) % GLAT, col = (i & 4095) * 3;
            v = bf2f(((const bf16_t*)(ws + OFF_PROJ))[row * PW + col]);
        } else if (DBG == 6) {
            if (i < (size_t)GLAT * 1024) { const size_t row = i >> 10, col = C_GLF + (i & 1023); v = bf2f(((const bf16_t*)(ws + OFF_PROJ))[row * PW + col]); }
            else if (i < (size_t)GLAT * 1024 + (size_t)GCTX * 4096) { const size_t j = i - (size_t)GLAT * 1024; const size_t row = GLAT + (j >> 12); const int cc = (int)(j & 4095);
                const int col = cc < 3072 ? 1024 + cc + (cc >= 2048 ? 1024 : 0) + 0 : (cc < 3584 ? C_GK + (cc - 3072) : C_GLF + (cc - 3584) * 2);
                v = bf2f(((const bf16_t*)(ws + OFF_PROJ))[row * PW + col]); }
        } else if (DBG == 3) {
            v = bf2f(((const bf16_t*)(ws + OFF_O))[i]);
        } else if (DBG == 4) {
            v = (i < (size_t)GLAT * 1024) ? p.out[i] : 0.f;
        } else if (DBG == 5) {
            v = (i < (size_t)NTOK * 128) ? (float)((const int*)(ws + OFF_SIDX))[i] : ((i < (size_t)NTOK * 256) ? ((const float*)(ws + OFF_SGATE))[i - (size_t)NTOK * 128] : 0.f);
        }
        if (!(fabsf(v) < 1e30f)) v = 12345.f;
        p.out[i] = v;
    }
}
constexpr int N_PHASES = 3 + NG * 5 + 5;

__global__ void __launch_bounds__(512, 2) mega(Params p) {
    extern __shared__ __attribute__((aligned(16))) char smem[];
    cg::grid_group grid = cg::this_grid();
    if (threadIdx.x < 4) ((unsigned*)(smem + 2 * HALF_SMEM))[threadIdx.x] = 0u;
    __syncthreads();
    const XcdBarrier xb = xcd_barrier_post((unsigned*)(p.ws + OFF_BAR), (volatile LAS unsigned*)(smem + 2 * HALF_SMEM));
    if (threadIdx.x == 0) {
        volatile unsigned* stw = (volatile unsigned*)(smem + 2 * HALF_SMEM);
        stw[2] = xb.x;
        stw[3] = __hip_atomic_fetch_add((unsigned*)(p.ws + OFF_BAR) + 3584 + xb.x, 1u, __ATOMIC_RELAXED, __HIP_MEMORY_SCOPE_AGENT);
    }
    if (p.phase_hi < 0) grid.sync();
    for (int ph = p.phase_lo; ph < p.phase_hi; ++ph) {
        if (ph == 99) phase_dump(p);
        else if (ph == 0) { phase_prep(p, smem); if (DUP == 8) { __syncthreads(); phase_prep(p, smem); } }
        else if (ph == 1) phase_modreduce(p);
        else if (ph == 2) phase_hprep(p, 0);
        else if (ph < 3 + NG * 5) {
            const int g = (ph - 3) / 5, s = (ph - 3) % 5;
            if (s == 0) phase_gemm_in(p, smem);
            else if (s == 1) phase_scan2(p, smem);
            else if (s == 2) {
                phase_headnorm(p);
                if (g + 1 < NG) phase_hprep(p, g + 1);
            } else if (s == 3) phase_branch(p, smem);
            else phase_outproj(p, g, smem);
        } else {
            const int s = ph - (3 + NG * 5);
            if (s == 0) phase_h2(p);
            else if (s == 1) phase_qproj(p, smem);
            else if (s == 2) phase_topk(p, smem);
            else if (s == 3) phase_peer_v(p, smem);
            else phase_final(p);
        }
        if (ph + 1 < p.phase_hi) {
            xcd_barrier(xb);
        }
    }
}

extern "C" void kernel_launch(void* const* d_in, const int* in_sizes, int n_in, void* d_out, int out_size, void* d_ws, size_t ws_size,
                              hipStream_t stream) {
    static int grid_blocks = 0;
    if (!grid_blocks) {
        int dev = 0, cus = 0, per_cu = 0;
        hipGetDevice(&dev);
        hipDeviceGetAttribute(&cus, hipDeviceAttributeMultiprocessorCount, dev);
        hipFuncSetAttribute((const void*)mega, hipFuncAttributeMaxDynamicSharedMemorySize, SMEM_BYTES);
        hipOccupancyMaxActiveBlocksPerMultiprocessor(&per_cu, mega, 512, SMEM_BYTES);
        if (per_cu > 1) per_cu = 1;
        if (per_cu < 1) per_cu = 1;
        grid_blocks = cus * per_cu;
    }
    Params p{};
    const float** f = (const float**)&p;
    for (int i = 0; i < 23; ++i) f[i] = (const float*)d_in[i];
    p.out = (float*)d_out;
    p.ws = (char*)d_ws;
    if (ws_size < WS_END) { fprintf(stderr, "workspace too small\n"); return; }
#ifdef MULTI_LAUNCH
    const int dbgK[7] = {N_PHASES, 2, 4, 5, 8, N_PHASES - 1, 4};
    for (int ph = 0; ph < dbgK[DBG]; ++ph) {
        p.phase_lo = ph;
        p.phase_hi = ph + 1;
        hipLaunchKernelGGL(mega, dim3(grid_blocks), dim3(512), SMEM_BYTES, stream, p);
    }
    if (DBG) {
        p.phase_lo = 99;
        p.phase_hi = 100;
        hipLaunchKernelGGL(mega, dim3(grid_blocks), dim3(512), SMEM_BYTES, stream, p);
    }
#else
    p.phase_lo = 0;
    p.phase_hi = N_PHASES;
    hipMemsetAsync((char*)d_ws + OFF_BAR, 0, 16384, stream);
    void* args[] = {&p};
    hipError_t e = hipLaunchCooperativeKernel((const void*)mega, dim3(grid_blocks), dim3(512), args, SMEM_BYTES, stream);
    if (e != hipSuccess) fprintf(stderr, "cooperative launch failed: %s (grid %d)\n", hipGetErrorString(e), grid_blocks);
#endif
}
```
